# Optimizing an MI355X kernel written in HIP

```python
import math
import jax, jax.numpy as jnp
from jax import lax
import numpy as np

D_MODEL = 1024
BATCH = 4
SEQ = 8192
DEPTH = 4

CHUNK = 64
MIX_WIDTH = D_MODEL
CONV_WIDTH = MIX_WIDTH // 2
CONV_GROUPS = 8
CONV_K = 31
RET_HEADS = 4
RET_DIM = (MIX_WIDTH - CONV_WIDTH) // RET_HEADS
RET_WIDTH = RET_HEADS * RET_DIM
IN_WIDTH = 2 * CONV_WIDTH + 4 * RET_WIDTH
D_FF = int(math.ceil(8 * D_MODEL / 3 / 256) * 256)
ROPE_BASE = 10000.0
EPS = 1e-6

kernel_name = 'hybrid_conformer_retention_encoder'


def rms_norm(x, g):
    xf = x.astype(jnp.float32)
    y = xf * lax.rsqrt(jnp.mean(xf * xf, axis=-1, keepdims=True) + EPS)
    return y.astype(x.dtype) * g


def layer_norm(x, g, b):
    xf = x.astype(jnp.float32)
    mu = jnp.mean(xf, axis=-1, keepdims=True)
    var = jnp.mean(jnp.square(xf - mu), axis=-1, keepdims=True)
    return ((xf - mu) * lax.rsqrt(var + EPS)).astype(x.dtype) * g + b


def causal_depthwise_conv(u, w, b):
    C = u.shape[-1]
    up = jnp.pad(u, ((0, 0), (CONV_K - 1, 0), (0, 0)))
    y = lax.conv_general_dilated(up, w[:, None, :].astype(u.dtype), window_strides=(1,),
                                 padding='VALID', dimension_numbers=('NWC', 'WIO', 'NWC'),
                                 feature_group_count=C)
    return y + b


def rotary(t, pos):
    half = t.shape[-1] // 2
    freqs = ROPE_BASE ** (-jnp.arange(half, dtype=jnp.float32) / half)
    ang = pos[:, None] * freqs[None, :]
    cos = jnp.cos(ang)[None, :, None, :]
    sin = jnp.sin(ang)[None, :, None, :]
    t1, t2 = t[..., :half], t[..., half:]
    return jnp.concatenate([t1 * cos - t2 * sin, t1 * sin + t2 * cos], axis=-1)


def chunk_retention(q, k, v):
    Bsz, S, H, Dk = q.shape
    Dv = v.shape[-1]
    NC = S // CHUNK

    def blk(t):
        return t.reshape(Bsz, NC, CHUNK, H, t.shape[-1]).transpose(0, 3, 1, 2, 4)

    q, k, v = blk(q), blk(k), blk(v)
    log_g = jnp.log(1.0 - 2.0 ** (-5.0 - jnp.arange(H, dtype=jnp.float32)))
    idx = jnp.arange(CHUNK, dtype=jnp.float32)
    intra_decay = jnp.exp(log_g[:, None, None] * jnp.abs(idx[:, None] - idx[None, :]))
    scores = jnp.einsum('bhnid,bhnjd->bhnij', q, k) * intra_decay[None, :, None]
    intra = jnp.einsum('bhnij,bhnje->bhnie', scores, v)

    k_dec = k * jnp.exp(log_g[:, None] * (CHUNK - 1 - idx))[None, :, None, :, None]
    kv = jnp.einsum('bhnjd,bhnje->nbhde', k_dec, v)
    chunk_decay = jnp.exp(log_g * CHUNK)[None, :, None, None]

    def step(state, kv_n):
        return chunk_decay * state + kv_n, state

    _, prev = lax.scan(step, jnp.zeros((Bsz, H, Dk, Dv), jnp.float32), kv)
    q_dec = q * jnp.exp(log_g[:, None] * (idx + 1.0))[None, :, None, :, None]
    cross = jnp.einsum('bhnid,nbhde->bhnie', q_dec, prev)
    return (intra + cross).transpose(0, 2, 3, 1, 4).reshape(Bsz, S, H, Dv)


def setup_inputs(seed: int = 0) -> dict:
    key = jax.random.key(seed)
    ks = jax.random.split(key, 16)
    f32 = jnp.float32
    n = lambda k, shape, s: jax.random.normal(k, shape, f32) * s
    return {
        'x': n(ks[0], (BATCH, SEQ, D_MODEL), 1.0),
        'norm1_g': 1.0 + n(ks[1], (DEPTH, D_MODEL), 0.02),
        'w_in': n(ks[2], (DEPTH, D_MODEL, IN_WIDTH), D_MODEL ** -0.5),
        'conv_w': n(ks[3], (DEPTH, CONV_K, CONV_WIDTH), CONV_K ** -0.5),
        'conv_b': n(ks[4], (DEPTH, CONV_WIDTH), 0.01),
        'conv_ln_g': 1.0 + n(ks[5], (DEPTH, CONV_WIDTH), 0.02),
        'conv_ln_b': n(ks[6], (DEPTH, CONV_WIDTH), 0.01),
        'ret_gn_g': 1.0 + n(ks[7], (DEPTH, RET_WIDTH), 0.02),
        'w_out': n(ks[8], (DEPTH, MIX_WIDTH, D_MODEL), (MIX_WIDTH * 2 * DEPTH) ** -0.5),
        'norm2_g': 1.0 + n(ks[9], (DEPTH, D_MODEL), 0.02),
        'w_gate': n(ks[10], (DEPTH, D_MODEL, D_FF), D_MODEL ** -0.5),
        'w_up': n(ks[11], (DEPTH, D_MODEL, D_FF), D_MODEL ** -0.5),
        'w_down': n(ks[12], (DEPTH, D_FF, D_MODEL), (D_FF * 2 * DEPTH) ** -0.5),
        'final_g': 1.0 + n(ks[13], (D_MODEL,), 0.02),
    }


def reference(x, norm1_g, w_in, conv_w, conv_b, conv_ln_g, conv_ln_b, ret_gn_g, w_out,
              norm2_g, w_gate, w_up, w_down, final_g):
    Bsz, S, _ = x.shape
    pos = jnp.arange(S, dtype=jnp.float32)
    cw, rw = CONV_WIDTH, RET_WIDTH
    for l in range(DEPTH):
        h = rms_norm(x, norm1_g[l])
        proj = h @ w_in[l]
        a = proj[..., :cw]
        b = proj[..., cw:2 * cw]
        q = proj[..., 2 * cw:2 * cw + rw]
        k = proj[..., 2 * cw + rw:2 * cw + 2 * rw]
        v = proj[..., 2 * cw + 2 * rw:2 * cw + 3 * rw]
        g = proj[..., 2 * cw + 3 * rw:]

        u = a * jax.nn.sigmoid(b)
        u = causal_depthwise_conv(u, conv_w[l], conv_b[l])
        u = jax.nn.silu(layer_norm(u, conv_ln_g[l], conv_ln_b[l]))

        qh = rotary(q.reshape(Bsz, S, RET_HEADS, RET_DIM).astype(jnp.float32), pos)
        kh = rotary(k.reshape(Bsz, S, RET_HEADS, RET_DIM).astype(jnp.float32), pos) * (RET_DIM ** -0.5)
        vh = v.reshape(Bsz, S, RET_HEADS, RET_DIM).astype(jnp.float32)
        r = chunk_retention(qh, kh, vh)
        mu = jnp.mean(r, axis=-1, keepdims=True)
        var = jnp.mean(jnp.square(r - mu), axis=-1, keepdims=True)
        r = ((r - mu) * lax.rsqrt(var + EPS)).reshape(Bsz, S, rw).astype(x.dtype)
        r = r * ret_gn_g[l] * jax.nn.silu(g)

        mixed = jnp.concatenate([u, r], axis=-1)
        x = x + mixed @ w_out[l]

        h2 = rms_norm(x, norm2_g[l])
        x = x + (jax.nn.silu(h2 @ w_gate[l]) * (h2 @ w_up[l])) @ w_down[l]
    return rms_norm(x, final_g)
```

```cpp
#include <hip/hip_runtime.h>
#include <hip/hip_cooperative_groups.h>
#include <cstdio>
namespace cg = cooperative_groups;

#define LAS __attribute__((address_space(3)))
#define DI __device__ __forceinline__
typedef unsigned short bf16_t;
typedef short bf16x8 __attribute__((ext_vector_type(8)));
typedef short s16x4 __attribute__((ext_vector_type(4)));
typedef float f32x4 __attribute__((ext_vector_type(4)));
typedef float f32x2 __attribute__((ext_vector_type(2)));
typedef unsigned u32x4 __attribute__((ext_vector_type(4)));
typedef unsigned u32x2 __attribute__((ext_vector_type(2)));

constexpr int MTOK = 32768, DM = 1024, SEQ = 8192, CWID = 512, RWID = 512, INW = 3072, DFF = 2816, NLAYER = 4, CONVK = 31;
constexpr float EPS = 1e-6f;
constexpr size_t SZ_WIN = (size_t)INW * DM * 2, SZ_WOUT = (size_t)DM * DM * 2, SZ_WGU = (size_t)2 * DFF * DM * 2, SZ_WDN = (size_t)DM * DFF * 2;
constexpr size_t OFF_WIN = 0, OFF_WOUT = OFF_WIN + NLAYER * SZ_WIN, OFF_WGU = OFF_WOUT + NLAYER * SZ_WOUT, OFF_WDN = OFF_WGU + NLAYER * SZ_WGU;
constexpr size_t OFF_XB = OFF_WDN + NLAYER * SZ_WDN;
constexpr size_t SZ_HALF = (size_t)MTOK * 512 * 2;
constexpr size_t OFF_ACT = OFF_XB + (size_t)MTOK * DM * 2;
constexpr size_t OFF_U0 = OFF_ACT, OFF_Q = OFF_U0 + SZ_HALF, OFF_K = OFF_Q + SZ_HALF, OFF_V = OFF_K + SZ_HALF, OFF_SG = OFF_V + SZ_HALF, OFF_MIX = OFF_SG + SZ_HALF;
constexpr size_t OFF_HID = OFF_ACT;
constexpr size_t OFF_ROWSQ = OFF_MIX + (size_t)MTOK * DM * 2;
constexpr size_t OFF_COS = OFF_ROWSQ + (size_t)9 * MTOK * 4, OFF_SIN = OFF_COS + (size_t)SEQ * 64 * 4;
constexpr size_t OFF_L = OFF_SIN + (size_t)SEQ * 64 * 4;
constexpr size_t OFF_BAR = OFF_L + (size_t)256 * 65536;
constexpr size_t OFF_XLO = OFF_BAR + 16384;
constexpr size_t WS_END = OFF_XLO + (size_t)MTOK * DM;
static_assert((size_t)MTOK * DFF * 2 <= OFF_ROWSQ - OFF_ACT, "HID alias too big");
constexpr int LDS_BYTES = 133120 + 256;

struct Params { const float* in[14]; float* out; unsigned char* ws; };

DI unsigned cvt_pk_bf16(float lo, float hi) { unsigned r; asm volatile("v_cvt_pk_bf16_f32 %0, %1, %2" : "=v"(r) : "v"(lo), "v"(hi)); return r; }
DI float bf_lo(unsigned w) { return __uint_as_float(w << 16); }
DI float bf_hi(unsigned w) { return __uint_as_float(w & 0xffff0000u); }
DI float fast_rcp(float x) { return __builtin_amdgcn_rcpf(x); }
DI float fexp(float x) { return __builtin_amdgcn_exp2f(x * 1.44269504089f); }
DI float sigmoidf_(float x) { return fast_rcp(1.0f + fexp(-x)); }
DI float siluf_(float x) { return x * sigmoidf_(x); }
DI float wave_sum(float v) {
#pragma unroll
  for (int o = 1; o < 64; o <<= 1) v += __shfl_xor(v, o);
  return v;
}

namespace pg8 {
constexpr int BM = 256, BK = 64, HALF = 128, HTB = HALF * BK * 2, STAGE_BYTES = 8 * HTB, NXCD = 8, WGM = 8;
DI int lds_byte(int r, int c) { const int st = (r >> 4) * 2 + (c >> 5), rr = r & 15, cc = c & 31, ob = rr * 64 + cc * 2; return st * 1024 + (ob ^ (((ob >> 9) & 1) << 5)); }
DI void stage_rc(int b, int& R, int& C) { const int st = b / 1024, sb = b % 1024, swz = sb ^ (((sb >> 9) & 1) << 5); R = (st >> 1) * 16 + swz / 64; C = (st & 1) * 32 + (swz % 64) / 2; }
DI int perm32(int rho) { const int n = rho >> 4, i = rho & 15; return 8 * (i >> 2) + 4 * n + (i & 3); }
struct Unit { int pm, pn; };
struct Gemm { const bf16_t* A; const bf16_t* Bt; int M, N, K; };
struct StaticOrder {
  int nM, nN, nwg, G, c;
  DI void init(int M, int N, int G_, int c_) { nM = M / BM; nN = N / BM; nwg = nM * nN; G = G_; c = c_; }
  DI bool next(int i, Unit& u) const {
    const long L = (long)i * G + c; if (L >= nwg) return false;
    int wgid = (int)L; { const int q = nwg / NXCD, r = nwg % NXCD, xcd = wgid % NXCD, off = wgid / NXCD; wgid = (xcd < r ? xcd * (q + 1) : r * (q + 1) + (xcd - r) * q) + off; }
    const int nig = WGM * nN, gid = wgid / nig, fm = gid * WGM, gsz = (nM - fm) < WGM ? (nM - fm) : WGM;
    u.pm = fm + ((wgid % nig) % gsz); u.pn = (wgid % nig) / gsz; return true;
  }
};

template <class Epi>
DI void gemm_phase(LAS unsigned char* lds, const Gemm g, const StaticOrder& S, const Epi& E) {
  int tid = threadIdx.x; asm volatile("" : "+v"(tid));
  const int wid = __builtin_amdgcn_readfirstlane(tid >> 6), lane = tid & 63, wr = wid >> 2, wc = wid & 3, fr = lane & 15, fq = lane >> 4;
  const int K = g.K, nt = K / BK;
  unsigned voffA[2], voffB[2];
#pragma unroll
  for (int i = 0; i < 2; ++i) { int R, C; stage_rc(tid * 16 + i * 8192, R, C); const int Rb = (R & ~31) + perm32(R & 31);
    voffA[i] = (unsigned)(R * K + C) * 2u; voffB[i] = (unsigned)(Rb * K + C) * 2u; }
  const size_t kstep = (size_t)(BK * 2);
  const size_t hstep = (size_t)HALF * K * 2;
  const size_t tstep = 2 * hstep;
  const unsigned ldsw = (unsigned)wid * 1024u;
  const int aoff = lds_byte(wr * 64 + fr, fq * 8), boff = lds_byte(wc * 32 + fr, fq * 8);
#define PG8_SA(b, h) (((b) * 2 + (h)) * HTB)
#define PG8_SB(b, h) ((4 + (b) * 2 + (h)) * HTB)
#define PG8_STAGE(bufoff, gbase, voff) do { _Pragma("unroll") for (int _i = 0; _i < 2; ++_i) \
        __builtin_amdgcn_global_load_lds((const unsigned*)((const char*)(gbase) + (voff)[_i]), (LAS unsigned*)(lds + (bufoff) + ldsw + _i * 8192), 16, 0, 0); } while (0)
#define PG8_LDA(dst, b, h) do { _Pragma("unroll") for (int m = 0; m < 4; ++m) _Pragma("unroll") for (int k = 0; k < 2; ++k) dst[m][k] = *(const LAS bf16x8*)(lds + PG8_SA(b, h) + aoff + m * 2048 + k * 1024); } while (0)
#define PG8_LDB(dst, b, h) do { _Pragma("unroll") for (int n = 0; n < 2; ++n) _Pragma("unroll") for (int k = 0; k < 2; ++k) dst[n][k] = *(const LAS bf16x8*)(lds + PG8_SB(b, h) + boff + n * 2048 + k * 1024); } while (0)
#define PG8_MMA(ai, bj, At, Bt) do { __builtin_amdgcn_s_setprio(1); _Pragma("unroll") for (int m = 0; m < 4; ++m) _Pragma("unroll") for (int n = 0; n < 2; ++n) _Pragma("unroll") for (int k = 0; k < 2; ++k) \
        acc[ai][bj][m][n] = __builtin_amdgcn_mfma_f32_16x16x32_bf16(Bt[n][k], At[m][k], acc[ai][bj][m][n], 0, 0, 0); __builtin_amdgcn_s_setprio(0); } while (0)
#define PG8_WAIT_V(n) asm volatile("s_waitcnt vmcnt(" #n ")" ::: "memory")
#define PG8_WAIT_L(n) asm volatile("s_waitcnt lgkmcnt(" #n ")" ::: "memory")
#define PG8_BAR __builtin_amdgcn_s_barrier()
#define PG8_SCHED __builtin_amdgcn_sched_barrier(0)
  Unit cur, nxt; int ui = 0;
  if (!S.next(0, cur)) return;
  f32x4 acc[2][2][4][2];
  float zf = 0.f; asm volatile("" : "+v"(zf));
#pragma unroll
  for (int a = 0; a < 2; ++a)
#pragma unroll
    for (int b = 0; b < 2; ++b)
#pragma unroll
      for (int m = 0; m < 4; ++m)
#pragma unroll
        for (int n = 0; n < 2; ++n) acc[a][b][m][n] = (f32x4){zf, zf, zf, zf};
  bf16x8 At[4][2], B0[2][2], B1[2][2];
  const char* cA = (const char*)g.A + (size_t)cur.pm * tstep; const char* cB = (const char*)g.Bt + (size_t)cur.pn * tstep;
  PG8_STAGE(PG8_SB(0, 0), cB, voffB); PG8_STAGE(PG8_SB(0, 1), cB + hstep, voffB); PG8_STAGE(PG8_SA(0, 0), cA, voffA); PG8_STAGE(PG8_SA(0, 1), cA + hstep, voffA);
  if (wr == 1) PG8_BAR;
  PG8_WAIT_V(2); PG8_BAR;
  PG8_STAGE(PG8_SB(1, 0), cB + kstep, voffB); PG8_STAGE(PG8_SA(1, 0), cA + kstep, voffA); PG8_STAGE(PG8_SB(1, 1), cB + hstep + kstep, voffB);
  PG8_WAIT_V(6); PG8_BAR;
  for (;;) {
    const bool has_next = S.next(ui + 1, nxt);
    const char* nA = has_next ? (const char*)g.A + (size_t)nxt.pm * tstep : cA; const char* nB = has_next ? (const char*)g.Bt + (size_t)nxt.pn * tstep : cB;
    asm volatile(".p2align 8");
    for (int t = 0; t < nt; t += 2) {
      const bool last = (t == nt - 2);
      const char* a1 = cA + (size_t)(t + 1) * kstep;
      const char* a2 = last ? nA : cA + (size_t)(t + 2) * kstep; const char* b2 = last ? nB : cB + (size_t)(t + 2) * kstep;
      const char* a3 = a2 + kstep; const char* b3 = b2 + kstep;
      PG8_LDB(B0, 0, 0); PG8_LDB(B1, 0, 1); PG8_SCHED; PG8_LDA(At, 0, 0); PG8_STAGE(PG8_SA(1, 1), a1 + hstep, voffA);
      PG8_WAIT_V(8); PG8_WAIT_L(0); PG8_BAR; PG8_MMA(0, 0, At, B0); PG8_MMA(0, 1, At, B1); PG8_BAR; PG8_SCHED;
      PG8_LDA(At, 0, 1); PG8_STAGE(PG8_SB(0, 0), b2, voffB); PG8_STAGE(PG8_SB(0, 1), b2 + hstep, voffB); PG8_STAGE(PG8_SA(0, 0), a2, voffA);
      PG8_WAIT_V(8); PG8_WAIT_L(0); PG8_BAR; PG8_MMA(1, 0, At, B0); PG8_MMA(1, 1, At, B1); PG8_BAR; PG8_SCHED;
      PG8_LDB(B0, 1, 0); PG8_LDB(B1, 1, 1); PG8_SCHED; PG8_LDA(At, 1, 0); PG8_STAGE(PG8_SA(0, 1), a2 + hstep, voffA);
      PG8_WAIT_V(8); PG8_WAIT_L(0); PG8_BAR; PG8_MMA(0, 0, At, B0); PG8_MMA(0, 1, At, B1); PG8_BAR; PG8_SCHED;
      PG8_LDA(At, 1, 1); PG8_STAGE(PG8_SB(1, 0), b3, voffB); PG8_STAGE(PG8_SB(1, 1), b3 + hstep, voffB); PG8_STAGE(PG8_SA(1, 0), a3, voffA);
      PG8_WAIT_V(8); PG8_WAIT_L(0); PG8_BAR; PG8_MMA(1, 0, At, B0); PG8_MMA(1, 1, At, B1); PG8_BAR; PG8_SCHED;
    }
    if (wr == 0) PG8_BAR;
    E(acc, cur, wr, wc, fr, fq);
    if (!has_next) break;
#pragma unroll
    for (int a = 0; a < 2; ++a)
#pragma unroll
      for (int b = 0; b < 2; ++b)
#pragma unroll
        for (int m = 0; m < 4; ++m)
#pragma unroll
          for (int n = 0; n < 2; ++n) acc[a][b][m][n] = (f32x4){zf, zf, zf, zf};
    cur = nxt; cA = nA; cB = nB; ++ui;
    if (wr == 1) PG8_BAR;
  }
  PG8_WAIT_V(0);
  PG8_BAR;
#undef PG8_SA
#undef PG8_SB
#undef PG8_STAGE
#undef PG8_LDA
#undef PG8_LDB
#undef PG8_MMA
#undef PG8_WAIT_V
#undef PG8_WAIT_L
#undef PG8_BAR
#undef PG8_SCHED
}
}

typedef f32x4 AccT[2][2][4][2];
DI u32x4 pack8(const f32x4 a, const f32x4 b) { u32x4 w; w.x = cvt_pk_bf16(a[0], a[1]); w.y = cvt_pk_bf16(a[2], a[3]); w.z = cvt_pk_bf16(b[0], b[1]); w.w = cvt_pk_bf16(b[2], b[3]); return w; }

struct EpiIn {
  const float* rowsq; bf16_t *u0, *q, *k, *v, *sg; const float *cs, *sn;
  DI void operator()(const AccT& acc, const pg8::Unit& u, int wr, int wc, int fr, int fq) const {
    const int row0 = u.pm * 256 + wr * 64 + fr, c8 = wc * 32 + 8 * fq, pn = u.pn;
    float rs[2][4];
#pragma unroll
    for (int ai = 0; ai < 2; ++ai)
#pragma unroll
      for (int m = 0; m < 4; ++m) rs[ai][m] = rowsq[row0 + ai * 128 + m * 16];
    __builtin_amdgcn_sched_barrier(0);
    if (pn >= 4 && pn < 8) {
      const int which = (pn - 4) >> 1, head = 2 * ((pn - 4) & 1) + (c8 >> 6), dd = c8 & 63;
      const float lg = which ? __log2f(1.0f - __builtin_amdgcn_exp2f(-5.0f - (float)head)) : 0.f;
#pragma unroll
      for (int ai = 0; ai < 2; ++ai)
#pragma unroll
      for (int mp = 0; mp < 2; ++mp) {
        f32x4 tc[2][2], ts[2][2];
#pragma unroll
        for (int m2 = 0; m2 < 2; ++m2) { const int pos = (row0 + ai * 128 + (2 * mp + m2) * 16) & (SEQ - 1);
          tc[m2][0] = *(const f32x4*)(cs + pos * 64 + dd); tc[m2][1] = *(const f32x4*)(cs + pos * 64 + dd + 4); ts[m2][0] = *(const f32x4*)(sn + pos * 64 + dd); ts[m2][1] = *(const f32x4*)(sn + pos * 64 + dd + 4); }
        __builtin_amdgcn_sched_barrier(0);
#pragma unroll
        for (int m2 = 0; m2 < 2; ++m2) {
          const int m = 2 * mp + m2;
          const int r = row0 + ai * 128 + m * 16;
          const float rstd = rsqrtf(rs[ai][m] * (1.0f / DM) + EPS);
          float sc = rstd;
          if (which) sc *= 0.08838834764831845f * __builtin_amdgcn_exp2f(lg * (float)(63 - (r & 63)));
          const f32x4 a0 = acc[ai][0][m][0] * sc, a1 = acc[ai][0][m][1] * sc, b0 = acc[ai][1][m][0] * sc, b1 = acc[ai][1][m][1] * sc;
          const f32x4 o1a = a0 * tc[m2][0] - b0 * ts[m2][0], o1b = a1 * tc[m2][1] - b1 * ts[m2][1], o2a = a0 * ts[m2][0] + b0 * tc[m2][0], o2b = a1 * ts[m2][1] + b1 * tc[m2][1];
          bf16_t* dst = (which ? k : q) + (size_t)r * 512 + head * 128 + dd;
          *(u32x4*)dst = pack8(o1a, o1b); *(u32x4*)(dst + 64) = pack8(o2a, o2b);
        }
        __builtin_amdgcn_sched_barrier(0);
      }
      return;
    }
#pragma unroll
    for (int ai = 0; ai < 2; ++ai)
#pragma unroll
      for (int m = 0; m < 4; ++m) {
        const int r = row0 + ai * 128 + m * 16;
        const float rstd = rsqrtf(rs[ai][m] * (1.0f / DM) + EPS);
        const f32x4 a0 = acc[ai][0][m][0] * rstd, a1 = acc[ai][0][m][1] * rstd, b0 = acc[ai][1][m][0] * rstd, b1 = acc[ai][1][m][1] * rstd;
        if (pn < 4) {
          f32x4 o0, o1;
#pragma unroll
          for (int j = 0; j < 4; ++j) { o0[j] = a0[j] * sigmoidf_(b0[j]); o1[j] = a1[j] * sigmoidf_(b1[j]); }
          *(u32x4*)(u0 + (size_t)r * 512 + pn * 128 + c8) = pack8(o0, o1);
        } else if (pn < 10) {
          bf16_t* dst = v + (size_t)r * 512 + (pn - 8) * 256 + c8;
          *(u32x4*)dst = pack8(a0, a1); *(u32x4*)(dst + 128) = pack8(b0, b1);
        } else {
          f32x4 o0, o1, o2, o3;
#pragma unroll
          for (int j = 0; j < 4; ++j) { o0[j] = siluf_(a0[j]); o1[j] = siluf_(a1[j]); o2[j] = siluf_(b0[j]); o3[j] = siluf_(b1[j]); }
          bf16_t* dst = sg + (size_t)r * 512 + (pn - 10) * 256 + c8;
          *(u32x4*)dst = pack8(o0, o1); *(u32x4*)(dst + 128) = pack8(o2, o3);
        }
      }
  }
};
DI float lo_scale_dn(unsigned hf_bits) { unsigned e = (hf_bits >> 23) & 0xffu; e = e < 16u ? 16u : e; return __uint_as_float((e - 15u) << 23); }
DI float lo_scale_up(unsigned hf_bits) { unsigned e = (hf_bits >> 23) & 0xffu; e = e < 16u ? 16u : e; return __uint_as_float((269u - e) << 23); }
DI void lo_decode8(const u32x4 h, const u32x2 q, f32x4& b0, f32x4& b1) {
  const unsigned hw[4] = {h.x, h.y, h.z, h.w}; float o[8];
#pragma unroll
  for (int t = 0; t < 4; ++t) {
    const unsigned fl = hw[t] << 16, fh = hw[t] & 0xffff0000u; const unsigned qq = t < 2 ? q.x : q.y; const int sh = (t & 1) * 16;
    const int ql = (int)(qq << (24 - sh)) >> 24, qh = (int)(qq << (16 - sh)) >> 24;
    o[2 * t] = __uint_as_float(fl) + (float)ql * lo_scale_dn(fl); o[2 * t + 1] = __uint_as_float(fh) + (float)qh * lo_scale_dn(fh);
  }
  b0 = (f32x4){o[0], o[1], o[2], o[3]}; b1 = (f32x4){o[4], o[5], o[6], o[7]};
}
DI void lo_encode8(const f32x4 x0, const f32x4 x1, u32x4& h, u32x2& q) {
  h = pack8(x0, x1);
  const unsigned hw[4] = {h.x, h.y, h.z, h.w}; const float xs[8] = {x0[0], x0[1], x0[2], x0[3], x1[0], x1[1], x1[2], x1[3]}; unsigned qb[2] = {0u, 0u};
#pragma unroll
  for (int t = 0; t < 4; ++t) {
    const unsigned fl = hw[t] << 16, fh = hw[t] & 0xffff0000u;
    int ql = (int)__builtin_rintf((xs[2 * t] - __uint_as_float(fl)) * lo_scale_up(fl)), qh = (int)__builtin_rintf((xs[2 * t + 1] - __uint_as_float(fh)) * lo_scale_up(fh));
    ql = ql < -127 ? -127 : (ql > 127 ? 127 : ql); qh = qh < -127 ? -127 : (qh > 127 ? 127 : qh);
    qb[t >> 1] |= (((unsigned)ql & 0xffu) | (((unsigned)qh & 0xffu) << 8)) << ((t & 1) * 16);
  }
  q.x = qb[0]; q.y = qb[1];
}
DI float sumsq8(const f32x4 x0, const f32x4 x1) { return (x0[0] * x0[0] + x0[1] * x0[1]) + (x0[2] * x0[2] + x0[3] * x0[3]) + (x1[0] * x1[0] + x1[1] * x1[1]) + (x1[2] * x1[2] + x1[3] * x1[3]); }
struct EpiRes {
  const float* base; float* out; bf16_t* hi; unsigned char* lo; float* rowsq_next; int in_f32, out_f32; const float* fg; unsigned* cnt;
  DI void operator()(const AccT& acc, const pg8::Unit& u, int wr, int wc, int fr, int fq) const {
    const int row0 = u.pm * 256 + wr * 64 + fr, col0 = u.pn * 256 + wc * 32 + 8 * fq;
    if (out_f32) {
      AccT& xa = const_cast<AccT&>(acc);
      { u32x4 lh[2][2]; u32x2 lq[2][2];
#define FIN_LOAD(st) do { _Pragma("unroll") for (int bj = 0; bj < 2; ++bj) { const unsigned off = (unsigned)((row0 + ((st) >> 2) * 128 + ((st) & 3) * 16) * DM + col0 + bj * 128); \
        lh[(st) & 1][bj] = *(const u32x4*)(hi + off); lq[(st) & 1][bj] = *(const u32x2*)(lo + off); } } while (0)
        FIN_LOAD(0);
#pragma unroll
        for (int st = 0; st < 8; ++st) {
          if (st < 7) FIN_LOAD(st + 1);
          __builtin_amdgcn_sched_barrier(0);
          const int ai = st >> 2, m = st & 3; const int r = row0 + ai * 128 + m * 16; float ss = 0.f;
#pragma unroll
          for (int bj = 0; bj < 2; ++bj) { f32x4 b0, b1; lo_decode8(lh[st & 1][bj], lq[st & 1][bj], b0, b1);
            xa[ai][bj][m][0] += b0; xa[ai][bj][m][1] += b1; ss += sumsq8(xa[ai][bj][m][0], xa[ai][bj][m][1]); }
          ss += __shfl_xor(ss, 16); ss += __shfl_xor(ss, 32);
          if (fq == 0) atomicAdd(rowsq_next + r, ss);
          __builtin_amdgcn_sched_barrier(0);
        }
#undef FIN_LOAD
      }
      asm volatile("s_waitcnt vmcnt(0)" ::: "memory");
      unsigned* pc = cnt + u.pm * 2 + wr;
      if (fr == 0 && fq == 0) __hip_atomic_fetch_add(pc, 1u, __ATOMIC_RELAXED, __HIP_MEMORY_SCOPE_AGENT);
      { unsigned sp = 0;
        while ((unsigned)__builtin_amdgcn_readfirstlane(__hip_atomic_load(pc, __ATOMIC_RELAXED, __HIP_MEMORY_SCOPE_AGENT)) < 16u) { __builtin_amdgcn_s_sleep(2); if (++sp > (1u << 22)) break; } }
      __builtin_amdgcn_fence(__ATOMIC_ACQUIRE, "agent");
      float rsv[2][4];
#pragma unroll
      for (int ai = 0; ai < 2; ++ai)
#pragma unroll
        for (int m = 0; m < 4; ++m) rsv[ai][m] = rsqrtf(__hip_atomic_load(rowsq_next + row0 + ai * 128 + m * 16, __ATOMIC_RELAXED, __HIP_MEMORY_SCOPE_AGENT) * (1.0f / DM) + EPS);
#pragma unroll
      for (int bj = 0; bj < 2; ++bj) {
        const f32x4 ga = *(const f32x4*)(fg + col0 + bj * 128), gb = *(const f32x4*)(fg + col0 + bj * 128 + 4);
        __builtin_amdgcn_sched_barrier(0);
#pragma unroll
        for (int ai = 0; ai < 2; ++ai)
#pragma unroll
          for (int m = 0; m < 4; ++m) { const unsigned off = (unsigned)((row0 + ai * 128 + m * 16) * DM + col0 + bj * 128);
            *(f32x4*)(out + off) = xa[ai][bj][m][0] * rsv[ai][m] * ga; *(f32x4*)(out + off + 4) = xa[ai][bj][m][1] * rsv[ai][m] * gb; }
        __builtin_amdgcn_sched_barrier(0);
      }
      return;
    }
    if (in_f32) {
      f32x4 lf[2][2][2];
#define INF_LOAD(st) do { _Pragma("unroll") for (int bj = 0; bj < 2; ++bj) { const unsigned off = (unsigned)((row0 + ((st) >> 2) * 128 + ((st) & 3) * 16) * DM + col0 + bj * 128); \
      lf[(st) & 1][bj][0] = *(const f32x4*)(base + off); lf[(st) & 1][bj][1] = *(const f32x4*)(base + off + 4); } } while (0)
      INF_LOAD(0);
#pragma unroll
      for (int st = 0; st < 8; ++st) {
        if (st < 7) INF_LOAD(st + 1);
        __builtin_amdgcn_sched_barrier(0);
        const int ai = st >> 2, m = st & 3; const int r = row0 + ai * 128 + m * 16; float ss = 0.f;
#pragma unroll
        for (int bj = 0; bj < 2; ++bj) { const unsigned off = (unsigned)(r * DM + col0 + bj * 128);
          const f32x4 x0 = lf[st & 1][bj][0] + acc[ai][bj][m][0], x1 = lf[st & 1][bj][1] + acc[ai][bj][m][1];
          u32x4 hw; u32x2 qw; lo_encode8(x0, x1, hw, qw); *(u32x4*)(hi + off) = hw; *(u32x2*)(lo + off) = qw; ss += sumsq8(x0, x1); }
        ss += __shfl_xor(ss, 16); ss += __shfl_xor(ss, 32);
        if (fq == 0) atomicAdd(rowsq_next + r, ss);
        __builtin_amdgcn_sched_barrier(0);
      }
#undef INF_LOAD
      return;
    }
    u32x4 lh[2][2]; u32x2 lq[2][2];
#define RES_LOAD(st) do { _Pragma("unroll") for (int bj = 0; bj < 2; ++bj) { const unsigned off = (unsigned)((row0 + ((st) >> 2) * 128 + ((st) & 3) * 16) * DM + col0 + bj * 128); \
      lh[(st) & 1][bj] = *(const u32x4*)(hi + off); lq[(st) & 1][bj] = *(const u32x2*)(lo + off); } } while (0)
#define RES_COMP(st) do { const int ai = (st) >> 2, m = (st) & 3; const int r = row0 + ai * 128 + m * 16; float ss = 0.f; _Pragma("unroll") for (int bj = 0; bj < 2; ++bj) { const unsigned off = (unsigned)(r * DM + col0 + bj * 128); \
      f32x4 b0, b1; lo_decode8(lh[(st) & 1][bj], lq[(st) & 1][bj], b0, b1); const f32x4 x0 = b0 + acc[ai][bj][m][0], x1 = b1 + acc[ai][bj][m][1]; u32x4 hw; u32x2 qw; lo_encode8(x0, x1, hw, qw); \
      *(u32x4*)(hi + off) = hw; *(u32x2*)(lo + off) = qw; ss += sumsq8(x0, x1); } \
      ss += __shfl_xor(ss, 16); ss += __shfl_xor(ss, 32); if (fq == 0) atomicAdd(rowsq_next + r, ss); } while (0)
    RES_LOAD(0);
#pragma unroll
    for (int st = 0; st < 8; ++st) {
      if (st < 7) RES_LOAD(st + 1);
      __builtin_amdgcn_sched_barrier(0);
      RES_COMP(st);
      __builtin_amdgcn_sched_barrier(0);
    }
#undef RES_LOAD
#undef RES_COMP
  }
};
struct EpiGU {
  const float* rowsq; bf16_t* hid;
  DI void operator()(const AccT& acc, const pg8::Unit& u, int wr, int wc, int fr, int fq) const {
    const int row0 = u.pm * 256 + wr * 64 + fr, c8 = wc * 32 + 8 * fq;
    float rs[2][4];
#pragma unroll
    for (int ai = 0; ai < 2; ++ai)
#pragma unroll
      for (int m = 0; m < 4; ++m) rs[ai][m] = rowsq[row0 + ai * 128 + m * 16];
    __builtin_amdgcn_sched_barrier(0);
#pragma unroll
    for (int ai = 0; ai < 2; ++ai)
#pragma unroll
      for (int m = 0; m < 4; ++m) {
        const int r = row0 + ai * 128 + m * 16;
        const float rstd = rsqrtf(rs[ai][m] * (1.0f / DM) + EPS);
        const f32x4 a0 = acc[ai][0][m][0] * rstd, a1 = acc[ai][0][m][1] * rstd, b0 = acc[ai][1][m][0] * rstd, b1 = acc[ai][1][m][1] * rstd;
        f32x4 o0, o1;
#pragma unroll
        for (int j = 0; j < 4; ++j) { o0[j] = siluf_(a0[j]) * b0[j]; o1[j] = siluf_(a1[j]) * b1[j]; }
        __builtin_nontemporal_store(pack8(o0, o1), (u32x4*)(hid + (size_t)r * DFF + u.pn * 128 + c8));
      }
  }
};

DI int map_win(int n) {
  if (n < 512) return 256 * (n >> 7) + (n & 127);
  if (n < 1024) { const int nn = n - 512; return 256 * (nn >> 7) + 128 + (nn & 127); }
  if (n < 2048) { const int which = (n - 1024) >> 9, nn = (n - 1024) & 511, head = nn >> 7, d = nn & 127; return 256 * (4 + 2 * which + (head >> 1)) + 128 * (d >> 6) + 64 * (head & 1) + (d & 63); }
  return n;
}
template <int MODE>
DI void transpose_item(const float* W, int K, int N, const float* gk, bf16_t* WT, LAS float* scr, int item, int lane) {
  const int nblk = N / 64, kb = item / nblk, nb = item % nblk, k0 = 64 * kb, n0 = 64 * nb;
  const float* src = W + (size_t)k0 * N + n0 + lane;
  float w[64];
#pragma unroll
  for (int i = 0; i < 64; ++i) w[i] = src[(size_t)i * N];
  if (gk) {
#pragma unroll
    for (int i = 0; i < 64; ++i) w[i] *= gk[k0 + i];
  }
#pragma unroll
  for (int i = 0; i < 64; ++i) scr[i * 65 + lane] = w[i];
  asm volatile("s_waitcnt lgkmcnt(0)" ::: "memory");
  const int c = lane & 7;
#pragma unroll
  for (int j = 0; j < 8; ++j) { const int n = (lane >> 3) + 8 * j; const LAS float* s = scr + (8 * c) * 65 + n;
    u32x4 o; o.x = cvt_pk_bf16(s[0 * 65], s[1 * 65]); o.y = cvt_pk_bf16(s[2 * 65], s[3 * 65]); o.z = cvt_pk_bf16(s[4 * 65], s[5 * 65]); o.w = cvt_pk_bf16(s[6 * 65], s[7 * 65]);
    const int ng = n0 + n;
    const int nm = MODE == 0 ? ng : MODE == 1 ? map_win(ng) : (256 * (ng >> 7) + (MODE == 3 ? 128 : 0) + (ng & 127));
    *(u32x4*)(WT + (size_t)nm * K + k0 + 8 * c) = o; }
  asm volatile("s_waitcnt lgkmcnt(0)" ::: "memory");
}
DI void phase_prologue(const Params& p, LAS unsigned char* lds) {
  int tid = threadIdx.x; asm volatile("" : "+v"(tid));
  const int lane = tid & 63, wave = tid >> 6;
  const int gw = blockIdx.x * 8 + wave, NGW = gridDim.x * 8;
  LAS float* scr = (LAS float*)(lds + wave * 16640);
  unsigned char* ws = p.ws;
  constexpr int I_IN = 16 * 48, I_OUT = 16 * 16, I_G = 16 * 44, I_DN = 44 * 16, I_LAYER = I_IN + I_OUT + 2 * I_G + I_DN;
  for (int it = gw; it < NLAYER * I_LAYER; it += NGW) {
    const int l = it / I_LAYER; int r = it % I_LAYER;
    if (r < I_IN) { transpose_item<1>(p.in[2] + (size_t)l * DM * INW, DM, INW, p.in[1] + l * DM, (bf16_t*)(ws + OFF_WIN + l * SZ_WIN), scr, r, lane); continue; } r -= I_IN;
    if (r < I_OUT) { transpose_item<0>(p.in[8] + (size_t)l * DM * DM, DM, DM, nullptr, (bf16_t*)(ws + OFF_WOUT + l * SZ_WOUT), scr, r, lane); continue; } r -= I_OUT;
    if (r < I_G) { transpose_item<2>(p.in[10] + (size_t)l * DM * DFF, DM, DFF, p.in[9] + l * DM, (bf16_t*)(ws + OFF_WGU + l * SZ_WGU), scr, r, lane); continue; } r -= I_G;
    if (r < I_G) { transpose_item<3>(p.in[11] + (size_t)l * DM * DFF, DM, DFF, p.in[9] + l * DM, (bf16_t*)(ws + OFF_WGU + l * SZ_WGU), scr, r, lane); continue; } r -= I_G;
    transpose_item<0>(p.in[12] + (size_t)l * DFF * DM, DFF, DM, nullptr, (bf16_t*)(ws + OFF_WDN + l * SZ_WDN), scr, r, lane);
  }
  const float* x = p.in[0]; bf16_t* xb = (bf16_t*)(ws + OFF_XB); float* rowsq = (float*)(ws + OFF_ROWSQ);
  for (int row = gw; row < MTOK; row += 2 * NGW) {
    const int row2 = row + NGW;
    const f32x4* xr = (const f32x4*)(x + (size_t)row * DM) + lane; u32x2* o = (u32x2*)(xb + (size_t)row * DM) + lane;
    const bool has2 = row2 < MTOK;
    const f32x4* xr2 = (const f32x4*)(x + (size_t)(has2 ? row2 : row) * DM) + lane; u32x2* o2 = (u32x2*)(xb + (size_t)(has2 ? row2 : row) * DM) + lane;
    f32x4 v[4], v2[4];
#pragma unroll
    for (int j = 0; j < 4; ++j) { v[j] = xr[64 * j]; v2[j] = xr2[64 * j]; }
    float s = 0.f, s2 = 0.f;
#pragma unroll
    for (int j = 0; j < 4; ++j) { s += (v[j][0] * v[j][0] + v[j][1] * v[j][1]) + (v[j][2] * v[j][2] + v[j][3] * v[j][3]); u32x2 w; w.x = cvt_pk_bf16(v[j][0], v[j][1]); w.y = cvt_pk_bf16(v[j][2], v[j][3]); o[64 * j] = w;
      s2 += (v2[j][0] * v2[j][0] + v2[j][1] * v2[j][1]) + (v2[j][2] * v2[j][2] + v2[j][3] * v2[j][3]); u32x2 w2; w2.x = cvt_pk_bf16(v2[j][0], v2[j][1]); w2.y = cvt_pk_bf16(v2[j][2], v2[j][3]); o2[64 * j] = w2; }
    s = wave_sum(s); s2 = wave_sum(s2);
    if (lane == 0) { rowsq[row] = s; if (has2) rowsq[row2] = s2; }
  }
  const int gt = blockIdx.x * 512 + tid, NGT = gridDim.x * 512;
  for (int i = gt; i < 8 * MTOK; i += NGT) rowsq[MTOK + i] = 0.f;
  float* cs = (float*)(ws + OFF_COS); float* sn = (float*)(ws + OFF_SIN);
  for (int i = gt; i < SEQ * 64; i += NGT) {
    const int pos = i >> 6, fi = i & 63;
    const double freq = exp(-(double)fi * (9.210340371976184 / 64.0));
    const double t = (double)pos * freq * 0.6366197723675814;
    const double qd = rint(t); const double r = (t - qd) * 1.5707963267948966; const double r2 = r * r;
    const double sv = r * (1.0 + r2 * (-1.0 / 6 + r2 * (1.0 / 120 + r2 * (-1.0 / 5040 + r2 * (1.0 / 362880 + r2 * (-1.0 / 39916800))))));
    const double cv = 1.0 + r2 * (-0.5 + r2 * (1.0 / 24 + r2 * (-1.0 / 720 + r2 * (1.0 / 40320 + r2 * (-1.0 / 3628800 + r2 * (1.0 / 479001600))))));
    const int qi = ((int)qd) & 3;
    const double s_ = qi == 0 ? sv : qi == 1 ? cv : qi == 2 ? -sv : -cv;
    const double c_ = qi == 0 ? cv : qi == 1 ? -sv : qi == 2 ? -cv : sv;
    cs[i] = (float)c_; sn[i] = (float)s_;
  }
}

DI void conv_load(const bf16_t* U0, int item, int tid, u32x4 (&pf)[8]) {
  const int b = item >> 8, t0 = (item & 255) * 32;
#pragma unroll
  for (int i = 0; i < 8; ++i) { const int id = tid + 512 * i, row = id >> 6, ch = id & 63, tok = t0 - 30 + row; const bool ok = (id < 62 * 64) && (tok >= 0);
    const u32x4 v = *(const u32x4*)(U0 + ((size_t)(b * SEQ + (ok ? tok : 0))) * 512 + ch * 8);
    pf[i] = ok ? v : (u32x4){0u, 0u, 0u, 0u}; }
}
DI void conv_items(const Params& p, int l, int first, int stride, int limit, LAS unsigned char* lds) {
  int tid = threadIdx.x; asm volatile("" : "+v"(tid));
  const int lane = tid & 63, wave = tid >> 6;
  const bf16_t* U0 = (const bf16_t*)(p.ws + OFF_U0); bf16_t* MIX = (bf16_t*)(p.ws + OFF_MIX);
  LAS unsigned char* in = lds;
  LAS float* st = (LAS float*)(lds + 63488);
  if (first >= limit) return;
  u32x4 pf[8];
  conv_load(U0, first, tid, pf);
  const int cs_ = tid >> 8, cp_ = tid & 255;
  f32x2 wv[CONVK];
  { const float* cw = p.in[3] + (size_t)l * CONVK * CWID + 2 * cp_;
#pragma unroll
    for (int j = 0; j < CONVK; ++j) wv[j] = *(const f32x2*)(cw + j * CWID); }
  const f32x2 bb = *(const f32x2*)(p.in[4] + l * CWID + 2 * cp_);
  const f32x4 g0 = *(const f32x4*)(p.in[5] + l * CWID + lane * 8), g1 = *(const f32x4*)(p.in[5] + l * CWID + lane * 8 + 4), b0 = *(const f32x4*)(p.in[6] + l * CWID + lane * 8), b1 = *(const f32x4*)(p.in[6] + l * CWID + lane * 8 + 4);
  for (int item = first; item < limit; item += stride) {
  const int b = item >> 8, t0 = (item & 255) * 32;
#pragma unroll
  for (int i = 0; i < 8; ++i) { const int id = tid + 512 * i; if (id < 62 * 64) *(LAS u32x4*)(in + (id >> 6) * 1024 + (id & 63) * 16) = pf[i]; }
  __syncthreads();
  if (item + stride < limit) conv_load(U0, item + stride, tid, pf);
  {
    const int s = cs_, cp = cp_;
    f32x2 av[16];
#pragma unroll
    for (int o = 0; o < 16; ++o) av[o] = bb;
#pragma unroll
    for (int ii = 0; ii < 46; ++ii) {
      const unsigned xw = *(const LAS unsigned*)(in + (16 * s + ii) * 1024 + cp * 4); const f32x2 xv = (f32x2){bf_lo(xw), bf_hi(xw)};
#pragma unroll
      for (int o = 0; o < 16; ++o) { const int j = ii - o; if (j >= 0 && j < CONVK) av[o] = __builtin_elementwise_fma(wv[j], xv, av[o]); }
    }
#pragma unroll
    for (int o = 0; o < 16; ++o) *(LAS f32x2*)(st + (16 * s + o) * 516 + 2 * cp) = av[o];
  }
  __syncthreads();
  {
#pragma unroll
    for (int tt = 0; tt < 4; ++tt) {
      const int oo = wave * 4 + tt;
      const LAS float* r = st + oo * 516 + lane * 8;
      const f32x4 A = *(const LAS f32x4*)r, B = *(const LAS f32x4*)(r + 4);
      float s1 = (A[0] + A[1]) + (A[2] + A[3]) + (B[0] + B[1]) + (B[2] + B[3]);
      float s2 = (A[0] * A[0] + A[1] * A[1]) + (A[2] * A[2] + A[3] * A[3]) + (B[0] * B[0] + B[1] * B[1]) + (B[2] * B[2] + B[3] * B[3]);
#pragma unroll
      for (int o = 1; o < 64; o <<= 1) { s1 += __shfl_xor(s1, o); s2 += __shfl_xor(s2, o); }
      const float mean = s1 * (1.0f / CWID);
      const float var = fmaxf(s2 * (1.0f / CWID) - mean * mean, 0.f);
      const f32x4 dA = A - mean, dB = B - mean;
      const float rstd = rsqrtf(var + EPS);
      f32x4 y0 = dA * rstd * g0 + b0, y1 = dB * rstd * g1 + b1;
#pragma unroll
      for (int j = 0; j < 4; ++j) { y0[j] = siluf_(y0[j]); y1[j] = siluf_(y1[j]); }
      *(u32x4*)(MIX + ((size_t)(b * SEQ + t0 + oo)) * DM + lane * 8) = pack8(y0, y1);
    }
  }
  __syncthreads();
  }
}

DI bf16x8 tr_pair(const LAS unsigned char* base, int row_stride) {
  const s16x4 lo = __builtin_amdgcn_ds_read_tr16_b64_v4i16((LAS s16x4*)base);
  const s16x4 hi = __builtin_amdgcn_ds_read_tr16_b64_v4i16((LAS s16x4*)(base + 4 * row_stride));
  return __builtin_shufflevector(lo, hi, 0, 1, 2, 3, 4, 5, 6, 7);
}
template <int PASS>
DI void ret_item(const Params& p, int l, int item, LAS unsigned char* lds) {
  constexpr int RS = 272, PS = 144;
  int tid = threadIdx.x; asm volatile("" : "+v"(tid));
  const int lane = tid & 63, wave = __builtin_amdgcn_readfirstlane(tid >> 6), g = lane >> 4, c16 = lane & 15, tq = c16 >> 2, tp = c16 & 3;
  const int b = item >> 6, h = (item >> 4) & 3, seg = item & 15;
  const size_t tokbase = (size_t)b * SEQ + seg * 512;
  const float log2g = __log2f(1.0f - __builtin_amdgcn_exp2f(-5.0f - (float)h));
  const bf16_t* Qg = (const bf16_t*)(p.ws + OFF_Q) + h * 128; const bf16_t* Kg = (const bf16_t*)(p.ws + OFF_K) + h * 128; const bf16_t* Vg = (const bf16_t*)(p.ws + OFF_V) + h * 128;
  const bf16_t* SGg = (const bf16_t*)(p.ws + OFF_SG) + h * 128; bf16_t* MIX = (bf16_t*)(p.ws + OFF_MIX) + 512 + h * 128;
  f32x4* Lb = (f32x4*)(p.ws + OFF_L);
  LAS unsigned char* Qs = lds; LAS unsigned char* Ks = lds + 17408; LAS unsigned char* Vs = lds + 34816; LAS unsigned char* Ps = lds + 52224; LAS unsigned char* Ss = lds + 61440;
  LAS float* stats = (LAS float*)(lds + 96256);
  u32x4 rq[2], rk[2], rv[2];
  f32x4 Sacc[8];
#define RET_LOAD(n) do { _Pragma("unroll") for (int i_ = 0; i_ < 2; ++i_) { const int id_ = tid + 512 * i_, j_ = id_ >> 4, ch_ = id_ & 15; const size_t o_ = (tokbase + (n) * 64 + j_) * 512 + ch_ * 8; \
      rk[i_] = *(const u32x4*)(Kg + o_); rv[i_] = *(const u32x4*)(Vg + o_); if (PASS == 2) rq[i_] = *(const u32x4*)(Qg + o_); } } while (0)
#define RET_STORE() do { _Pragma("unroll") for (int i_ = 0; i_ < 2; ++i_) { const int id_ = tid + 512 * i_, j_ = id_ >> 4, ch_ = id_ & 15; \
      *(LAS u32x4*)(Ks + j_ * RS + ch_ * 16) = rk[i_]; *(LAS u32x4*)(Vs + j_ * RS + ch_ * 16) = rv[i_]; if (PASS == 2) *(LAS u32x4*)(Qs + j_ * RS + ch_ * 16) = rq[i_]; } } while (0)
#define RET_WRITE_S() do { _Pragma("unroll") for (int dt_ = 0; dt_ < 8; ++dt_) { u32x2 w_; w_.x = cvt_pk_bf16(Sacc[dt_][0], Sacc[dt_][1]); w_.y = cvt_pk_bf16(Sacc[dt_][2], Sacc[dt_][3]); \
      *(LAS u32x2*)(Ss + (16 * dt_ + c16) * RS + (16 * wave + 4 * g) * 2) = w_; } } while (0)
  RET_LOAD(0);
  const int it_c = wave & 3, eh_c = wave >> 2, i_c = 16 * it_c + c16;
  u32x2 sg_cur[4], sg_nxt[4]; f32x4 gnv[4];
  if (PASS == 2) {
#pragma unroll
    for (int et = 0; et < 4; ++et) { const int e0 = 64 * eh_c + 16 * et + 4 * g; gnv[et] = *(const f32x4*)(p.in[7] + l * RWID + h * 128 + e0); sg_nxt[et] = *(const u32x2*)(SGg + (tokbase + i_c) * 512 + e0); }
  }
#pragma unroll
  for (int dt = 0; dt < 8; ++dt) Sacc[dt] = (f32x4){0.f, 0.f, 0.f, 0.f};
  if (PASS == 2) {
    const f32x4* Lp = Lb + (size_t)item * 4096 + (wave * 8) * 64 + lane;
#pragma unroll
    for (int dt = 0; dt < 8; ++dt) Sacc[dt] = Lp[dt * 64];
  }
  RET_STORE();
  if (PASS == 2) RET_WRITE_S();
  __syncthreads();
  const float g64 = __builtin_amdgcn_exp2f(log2g * 64.0f);
  float dB[2][4]; float gi_c = 0.f;
  if (PASS == 2) {
    const int jt_ = wave >> 1, it0_ = 2 * (wave & 1);
#pragma unroll
    for (int t = 0; t < 2; ++t)
#pragma unroll
      for (int r = 0; r < 4; ++r) { const int i = 16 * (it0_ + t) + c16, j = 16 * jt_ + 4 * g + r; dB[t][r] = __builtin_amdgcn_exp2f(log2g * (float)((i > j ? i - j : j - i) + j - 63)); }
    gi_c = __builtin_amdgcn_exp2f(log2g * (float)(i_c + 1));
  }
  for (int n = 0; n < 8; ++n) {
    if (n < 7) RET_LOAD(n + 1);
    if (PASS == 2) {
#pragma unroll
      for (int et = 0; et < 4; ++et) { sg_cur[et] = sg_nxt[et]; if (n < 7) sg_nxt[et] = *(const u32x2*)(SGg + (tokbase + (n + 1) * 64 + i_c) * 512 + 64 * eh_c + 16 * et + 4 * g); }
      {
        const int jt = wave >> 1, it0 = 2 * (wave & 1);
        f32x4 sacc[2] = {(f32x4){0.f, 0.f, 0.f, 0.f}, (f32x4){0.f, 0.f, 0.f, 0.f}};
        bf16x8 ka[4], qb[2][4];
#pragma unroll
        for (int ks = 0; ks < 4; ++ks) { ka[ks] = *(const LAS bf16x8*)(Ks + (16 * jt + c16) * RS + (32 * ks + 8 * g) * 2);
#pragma unroll
          for (int t = 0; t < 2; ++t) qb[t][ks] = *(const LAS bf16x8*)(Qs + (16 * (it0 + t) + c16) * RS + (32 * ks + 8 * g) * 2); }
        __builtin_amdgcn_sched_barrier(0);
#pragma unroll
        for (int ks = 0; ks < 4; ++ks)
#pragma unroll
          for (int t = 0; t < 2; ++t) sacc[t] = __builtin_amdgcn_mfma_f32_16x16x32_bf16(ka[ks], qb[t][ks], sacc[t], 0, 0, 0);
        __builtin_amdgcn_sched_barrier(0);
#pragma unroll
        for (int t = 0; t < 2; ++t) { const int i = 16 * (it0 + t) + c16; float pv[4];
#pragma unroll
          for (int r = 0; r < 4; ++r) pv[r] = sacc[t][r] * dB[t][r];
          u32x2 w_; w_.x = cvt_pk_bf16(pv[0], pv[1]); w_.y = cvt_pk_bf16(pv[2], pv[3]);
          *(LAS u32x2*)(Ps + i * PS + (16 * jt + 4 * g) * 2) = w_; }
      }
    }
    f32x4 accI[4], accX[4];
    const int it = wave & 3, eh = wave >> 2, i = 16 * it + c16;
    if (PASS == 2) {
#pragma unroll
      for (int et = 0; et < 4; ++et) { accI[et] = (f32x4){0.f, 0.f, 0.f, 0.f}; accX[et] = (f32x4){0.f, 0.f, 0.f, 0.f}; }
#pragma unroll
      for (int kh = 0; kh < 2; ++kh) {
        bf16x8 bq[2], as_[2][4];
#pragma unroll
        for (int k2 = 0; k2 < 2; ++k2) { const int ks = 2 * kh + k2; bq[k2] = *(const LAS bf16x8*)(Qs + i * RS + (32 * ks + 8 * g) * 2);
#pragma unroll
          for (int et = 0; et < 4; ++et) as_[k2][et] = tr_pair(Ss + (32 * ks + 8 * g + tq) * RS + (64 * eh + 16 * et + 4 * tp) * 2, RS); }
        __builtin_amdgcn_sched_barrier(0);
#pragma unroll
        for (int k2 = 0; k2 < 2; ++k2)
#pragma unroll
          for (int et = 0; et < 4; ++et) accX[et] = __builtin_amdgcn_mfma_f32_16x16x32_bf16(as_[k2][et], bq[k2], accX[et], 0, 0, 0);
        __builtin_amdgcn_sched_barrier(0);
      }
    }
    if (PASS == 1 || n < 7) {
#pragma unroll
      for (int dt = 0; dt < 8; ++dt) Sacc[dt] *= g64;
#pragma unroll
      for (int ks = 0; ks < 2; ++ks) {
        bf16x8 bk[8];
        const bf16x8 a = tr_pair(Vs + (32 * ks + 8 * g + tq) * RS + (16 * wave + 4 * tp) * 2, RS);
#pragma unroll
        for (int dt = 0; dt < 8; ++dt) bk[dt] = tr_pair(Ks + (32 * ks + 8 * g + tq) * RS + (16 * dt + 4 * tp) * 2, RS);
        __builtin_amdgcn_sched_barrier(0);
#pragma unroll
        for (int dt = 0; dt < 8; ++dt) Sacc[dt] = __builtin_amdgcn_mfma_f32_16x16x32_bf16(a, bk[dt], Sacc[dt], 0, 0, 0);
        __builtin_amdgcn_sched_barrier(0);
      }
    }
    __syncthreads();
    if (PASS == 2) {
      {
        bf16x8 bp[2], av[2][4];
#pragma unroll
        for (int ks = 0; ks < 2; ++ks) { bp[ks] = *(const LAS bf16x8*)(Ps + i * PS + (32 * ks + 8 * g) * 2);
#pragma unroll
          for (int et = 0; et < 4; ++et) av[ks][et] = tr_pair(Vs + (32 * ks + 8 * g + tq) * RS + (64 * eh + 16 * et + 4 * tp) * 2, RS); }
        __builtin_amdgcn_sched_barrier(0);
#pragma unroll
        for (int ks = 0; ks < 2; ++ks)
#pragma unroll
          for (int et = 0; et < 4; ++et) accI[et] = __builtin_amdgcn_mfma_f32_16x16x32_bf16(av[ks][et], bp[ks], accI[et], 0, 0, 0);
        __builtin_amdgcn_sched_barrier(0);
      }
      const float gi = gi_c;
      float s1 = 0.f, s2 = 0.f;
#pragma unroll
      for (int et = 0; et < 4; ++et) { accI[et] += accX[et] * gi;
        s1 += (accI[et][0] + accI[et][1]) + (accI[et][2] + accI[et][3]);
        s2 += (accI[et][0] * accI[et][0] + accI[et][1] * accI[et][1]) + (accI[et][2] * accI[et][2] + accI[et][3] * accI[et][3]); }
      s1 += __shfl_xor(s1, 16); s1 += __shfl_xor(s1, 32); s2 += __shfl_xor(s2, 16); s2 += __shfl_xor(s2, 32);
      if (g == 0) { stats[(eh * 64 + i) * 2] = s1; stats[(eh * 64 + i) * 2 + 1] = s2; }
      __syncthreads();
      const float t1 = stats[i * 2] + stats[(64 + i) * 2], t2 = stats[i * 2 + 1] + stats[(64 + i) * 2 + 1];
      const float mean = t1 * (1.0f / 128.0f), var = fmaxf(t2 * (1.0f / 128.0f) - mean * mean, 0.f), rstd = rsqrtf(var + EPS);
      const size_t tok = tokbase + n * 64 + i;
#pragma unroll
      for (int et = 0; et < 4; ++et) { const int e0 = 64 * eh + 16 * et + 4 * g;
        const f32x4 gn = gnv[et]; const u32x2 sgw = sg_cur[et];
        const float v0 = (accI[et][0] - mean) * rstd * gn[0] * bf_lo(sgw.x), v1 = (accI[et][1] - mean) * rstd * gn[1] * bf_hi(sgw.x);
        const float v2 = (accI[et][2] - mean) * rstd * gn[2] * bf_lo(sgw.y), v3 = (accI[et][3] - mean) * rstd * gn[3] * bf_hi(sgw.y);
        u32x2 w_; w_.x = cvt_pk_bf16(v0, v1); w_.y = cvt_pk_bf16(v2, v3);
        *(u32x2*)(MIX + tok * DM + e0) = w_; }
    }
    if (n < 7) { RET_STORE(); if (PASS == 2) RET_WRITE_S(); }
    __syncthreads();
  }
  if (PASS == 1) {
    f32x4* Lp = Lb + (size_t)item * 4096 + (wave * 8) * 64 + lane;
#pragma unroll
    for (int dt = 0; dt < 8; ++dt) Lp[dt * 64] = Sacc[dt];
  }
#undef RET_LOAD
#undef RET_STORE
#undef RET_WRITE_S
}


DI void ret_scan(const Params& p) {
  f32x4* Lb = (f32x4*)(p.ws + OFF_L);
  int tid_ = threadIdx.x; asm volatile("" : "+v"(tid_));
  const int gt = blockIdx.x * 512 + tid_, NGT = gridDim.x * 512;
  for (int idx = gt; idx < 16 * 4096; idx += NGT) {
    const int bh = idx >> 12, e = idx & 4095, h = bh & 3;
    f32x4* base = Lb + (size_t)bh * 16 * 4096 + e;
    const float g512 = __builtin_amdgcn_exp2f(__log2f(1.0f - __builtin_amdgcn_exp2f(-5.0f - (float)h)) * 512.0f);
    f32x4 v[15];
#pragma unroll
    for (int s_ = 0; s_ < 15; ++s_) v[s_] = base[(size_t)s_ * 4096];
    float z_ = 0.f; asm volatile("" : "+v"(z_));
    f32x4 a = (f32x4){z_, z_, z_, z_};
    base[0] = a;
#pragma unroll
    for (int s_ = 0; s_ < 15; ++s_) { a = a * g512 + v[s_]; base[(size_t)(s_ + 1) * 4096] = a; }
  }
}

#define XB_TMO      128
#define XB_XCNT(j)  (256  + 64 * (j))
#define XB_XSUB(j)  (1280 + 64 * (j))
#define XB_XGEN(j)  (2304 + 64 * (j))
#define XB_TOP      3328
#define XB_TOPGEN   3392
#define XCD_BAR_WORDS 3456
#define XB_SPIN_CAP (1u << 18)
DI unsigned xb_ld(unsigned* p)              { return __hip_atomic_load(p, __ATOMIC_RELAXED, __HIP_MEMORY_SCOPE_AGENT); }
DI unsigned xb_add(unsigned* p, unsigned v) { return __hip_atomic_fetch_add(p, v, __ATOMIC_RELAXED, __HIP_MEMORY_SCOPE_AGENT); }
DI unsigned xb_xcc_id() { return (unsigned)__builtin_amdgcn_s_getreg((3 << 11) | 20) & 0xFu; }
#define XB_SPIN(cond, bar) do { unsigned _sp = 0; while (cond) { __builtin_amdgcn_s_sleep(1); \
    if ((++_sp & 255u) == 0u) { if (xb_ld(&(bar)[XB_TMO])) break; if (_sp > XB_SPIN_CAP) { atomicAdd(&(bar)[XB_TMO], 1u); break; } } } } while (0)
struct XcdBarrier { unsigned* bar; unsigned x; volatile LAS unsigned* st; };
DI XcdBarrier xcd_barrier_post(unsigned* bar, volatile LAS unsigned* st) {
  XcdBarrier b; b.bar = bar; b.x = xb_xcc_id(); b.st = st;
  if (threadIdx.x == 0) (void)xb_add(&bar[XB_XCNT(b.x)], 1u);
  return b;
}
DI void xcd_barrier_complete(unsigned* bar, unsigned x, unsigned& nloc, unsigned& nx) {
  const unsigned G = gridDim.x * gridDim.y * gridDim.z;
  unsigned sum, cnt, mine, sp = 0u;
  for (;;) {
    sum = 0u; cnt = 0u; mine = 0u;
#pragma unroll
    for (unsigned j = 0; j < 16; ++j) { const unsigned c = xb_ld(&bar[XB_XCNT(j)]); sum += c; cnt += (c > 0u) ? 1u : 0u; mine = (j == x) ? c : mine; }
    if (sum == G) break;
    __builtin_amdgcn_s_sleep(1);
    if ((++sp & 255u) == 0u) { if (xb_ld(&bar[XB_TMO])) break; if (sp > XB_SPIN_CAP) { atomicAdd(&bar[XB_TMO], 1u); break; } }
  }
  nloc = mine > 0u ? mine : 1u; nx = cnt > 0u ? cnt : 1u;
}
DI void xcd_barrier(const XcdBarrier& b) {
  asm volatile("s_waitcnt vmcnt(0)" ::: "memory");
  __syncthreads();
  if (threadIdx.x == 0) {
    unsigned* bar = b.bar;
    __builtin_amdgcn_s_waitcnt(0);
    unsigned nloc = b.st[0], nx = b.st[1];
    if (nloc == 0u) { xcd_barrier_complete(bar, b.x, nloc, nx); b.st[0] = nloc; b.st[1] = nx; }
    const unsigned old = xb_add(&bar[XB_XSUB(b.x)], 1u);
    const unsigned gen = old / nloc;
    if (old + 1u == (gen + 1u) * nloc) {
      __builtin_amdgcn_fence(__ATOMIC_RELEASE, "agent");
      asm volatile("s_waitcnt vmcnt(0)" ::: "memory");
      const unsigned og = xb_add(&bar[XB_TOP], 1u);
      const unsigned tg = og / nx;
      if (og + 1u == (tg + 1u) * nx) xb_add(&bar[XB_TOPGEN], 1u);
      else XB_SPIN(xb_ld(&bar[XB_TOPGEN]) == tg, bar);
      __builtin_amdgcn_fence(__ATOMIC_ACQUIRE, "agent");
      xb_add(&bar[XB_XGEN(b.x)], 1u);
      asm volatile("s_waitcnt vmcnt(0)" ::: "memory");
    } else {
      XB_SPIN(xb_ld(&bar[XB_XGEN(b.x)]) == gen, bar);
      __builtin_amdgcn_fence(__ATOMIC_ACQUIRE, "agent");
      asm volatile("s_waitcnt vmcnt(0)" ::: "memory");
    }
  }
  __syncthreads();
}

extern __shared__ __attribute__((aligned(16))) unsigned char smem_dyn[];

__global__ void __launch_bounds__(512) fwd_mega(Params p) {
  cg::grid_group grid = cg::this_grid();
  LAS unsigned char* lds = (LAS unsigned char*)smem_dyn;
  unsigned char* ws = p.ws;
  float* rowsq = (float*)(ws + OFF_ROWSQ);
  bf16_t* XB = (bf16_t*)(ws + OFF_XB); unsigned char* XLO = ws + OFF_XLO;
  const int G = gridDim.x, c = blockIdx.x;
  volatile LAS unsigned* bst = (volatile LAS unsigned*)(lds + 133120);
  if (threadIdx.x == 0) { bst[0] = 0u; bst[1] = 0u; }
  __syncthreads();
  const XcdBarrier xbar = xcd_barrier_post((unsigned*)(ws + OFF_BAR), bst);
#define GSYNC() xcd_barrier(xbar)

  phase_prologue(p, lds);
  grid.sync();

  for (int l = 0; l < NLAYER; ++l) {
    { pg8::Gemm gm{XB, (const bf16_t*)(ws + OFF_WIN + l * SZ_WIN), MTOK, INW, DM};
      pg8::StaticOrder so; so.init(MTOK, INW, G, c);
      EpiIn e{rowsq + (size_t)(2 * l) * MTOK, (bf16_t*)(ws + OFF_U0), (bf16_t*)(ws + OFF_Q), (bf16_t*)(ws + OFF_K), (bf16_t*)(ws + OFF_V), (bf16_t*)(ws + OFF_SG), (const float*)(ws + OFF_COS), (const float*)(ws + OFF_SIN)};
      pg8::gemm_phase(lds, gm, so, e); }
    GSYNC();
    for (int it = c; it < 256; it += G) ret_item<1>(p, l, it, lds);
    if (G == 256) { const int x_ = c & 7, j_ = c >> 3; conv_items(p, l, 128 * x_ + j_, 32, 128 * x_ + 128, lds); }
    else conv_items(p, l, c, G, 1024, lds);
    GSYNC();
    ret_scan(p);
    GSYNC();
    for (int it = c; it < 256; it += G) ret_item<2>(p, l, it, lds);
    GSYNC();
    { pg8::Gemm gm{(const bf16_t*)(ws + OFF_MIX), (const bf16_t*)(ws + OFF_WOUT + l * SZ_WOUT), MTOK, DM, DM};
      pg8::StaticOrder so; so.init(MTOK, DM, G, c);
      EpiRes e{p.in[0], p.out, XB, XLO, rowsq + (size_t)(2 * l + 1) * MTOK, l == 0, 0, p.in[13], (unsigned*)(ws + OFF_BAR) + 3584};
      pg8::gemm_phase(lds, gm, so, e);
 }
    GSYNC();
    { pg8::Gemm gm{XB, (const bf16_t*)(ws + OFF_WGU + l * SZ_WGU), MTOK, 2 * DFF, DM};
      pg8::StaticOrder so; so.init(MTOK, 2 * DFF, G, c);
      EpiGU e{rowsq + (size_t)(2 * l + 1) * MTOK, (bf16_t*)(ws + OFF_HID)};
      pg8::gemm_phase(lds, gm, so, e);
 }
    GSYNC();
    { pg8::Gemm gm{(const bf16_t*)(ws + OFF_HID), (const bf16_t*)(ws + OFF_WDN + l * SZ_WDN), MTOK, DM, DFF};
      pg8::StaticOrder so; so.init(MTOK, DM, G, c);
      EpiRes e{p.in[0], p.out, XB, XLO, rowsq + (size_t)(2 * l + 2) * MTOK, 0, l == NLAYER - 1, p.in[13], (unsigned*)(ws + OFF_BAR) + 3584};
      pg8::gemm_phase(lds, gm, so, e);
 }
    if (l < NLAYER - 1) GSYNC();
  }
}

extern "C" void kernel_launch(void* const* d_in, const int* in_sizes, int n_in, void* d_out, int out_size, void* d_ws, size_t ws_size, hipStream_t stream) {
  static int grid_blocks = 0;
  if (!grid_blocks) {
    int dev = 0, cus = 0, per_cu = 0;
    (void)hipGetDevice(&dev);
    (void)hipDeviceGetAttribute(&cus, hipDeviceAttributeMultiprocessorCount, dev);
    (void)hipFuncSetAttribute((const void*)fwd_mega, hipFuncAttributeMaxDynamicSharedMemorySize, LDS_BYTES);
    (void)hipOccupancyMaxActiveBlocksPerMultiprocessor(&per_cu, (const void*)fwd_mega, 512, LDS_BYTES);
    if (n_in != 14 || out_size != MTOK * DM || ws_size < WS_END) { fprintf(stderr, "kernel_launch: unexpected shapes (n_in %d out %d ws %zu need %zu)\n", n_in, out_size, ws_size, (size_t)WS_END); grid_blocks = -1; return; }
    grid_blocks = cus;
    fprintf(stderr, "kernel_launch: cus %d per_cu %d grid %d\n", cus, per_cu, grid_blocks);
  }
  if (grid_blocks < 0) return;
  (void)hipMemsetAsync((unsigned char*)d_ws + OFF_BAR, 0, 16384, stream);
  Params p{};
  for (int i = 0; i < 14; ++i) p.in[i] = (const float*)d_in[i];
  p.out = (float*)d_out; p.ws = (unsigned char*)d_ws;
  void* args[] = {&p};
  hipError_t e = hipLaunchCooperativeKernel((void*)fwd_mega, dim3(grid_blocks), dim3(512), args, LDS_BYTES, stream);
  if (e != hipSuccess) fprintf(stderr, "cooperative launch failed: %s (grid %d)\n", hipGetErrorString(e), grid_blocks);
}
```

```cpp
#include <hip/hip_runtime.h>
#include <hip/hip_cooperative_groups.h>
#include <cstdio>
namespace cg = cooperative_groups;

#define LAS __attribute__((address_space(3)))
#define DI __device__ __forceinline__
typedef unsigned short bf16_t;
typedef short bf16x8 __attribute__((ext_vector_type(8)));
typedef short s16x4 __attribute__((ext_vector_type(4)));
typedef float f32x4 __attribute__((ext_vector_type(4)));
typedef float f32x2 __attribute__((ext_vector_type(2)));
typedef unsigned u32x4 __attribute__((ext_vector_type(4)));
typedef unsigned u32x2 __attribute__((ext_vector_type(2)));

constexpr int MTOK = 32768, DM = 1024, SEQ = 8192, CWID = 512, RWID = 512, INW = 3072, DFF = 2816, NLAYER = 4, CONVK = 31;
constexpr float EPS = 1e-6f;
constexpr size_t SZ_WIN = (size_t)INW * DM * 2, SZ_WOUT = (size_t)DM * DM * 2, SZ_WGU = (size_t)2 * DFF * DM * 2, SZ_WDN = (size_t)DM * DFF * 2;
constexpr size_t OFF_WIN = 0, OFF_WOUT = OFF_WIN + NLAYER * SZ_WIN, OFF_WGU = OFF_WOUT + NLAYER * SZ_WOUT, OFF_WDN = OFF_WGU + NLAYER * SZ_WGU;
constexpr size_t OFF_XB = OFF_WDN + NLAYER * SZ_WDN;
constexpr size_t SZ_HALF = (size_t)MTOK * 512 * 2;
constexpr size_t OFF_ACT = OFF_XB + (size_t)MTOK * DM * 2;
constexpr size_t OFF_U0 = OFF_ACT, OFF_Q = OFF_U0 + SZ_HALF, OFF_K = OFF_Q + SZ_HALF, OFF_V = OFF_K + SZ_HALF, OFF_SG = OFF_V + SZ_HALF, OFF_MIX = OFF_SG + SZ_HALF;
constexpr size_t OFF_HID = OFF_ACT;
constexpr size_t OFF_ROWSQ = OFF_MIX + (size_t)MTOK * DM * 2;
constexpr size_t OFF_COS = OFF_ROWSQ + (size_t)9 * MTOK * 4, OFF_SIN = OFF_COS + (size_t)SEQ * 64 * 4;
constexpr size_t OFF_L = OFF_SIN + (size_t)SEQ * 64 * 4;
constexpr size_t OFF_BAR = OFF_L + (size_t)256 * 65536;
constexpr size_t OFF_XLO = OFF_BAR + 16384;
constexpr size_t WS_END = OFF_XLO + (size_t)MTOK * DM;
static_assert((size_t)MTOK * DFF * 2 <= OFF_ROWSQ - OFF_ACT, "HID alias too big");
constexpr int LDS_BYTES = 133120 + 256;

struct Params { const float* in[14]; float* out; unsigned char* ws; };

DI unsigned cvt_pk_bf16(float lo, float hi) { unsigned r; asm volatile("v_cvt_pk_bf16_f32 %0, %1, %2" : "=v"(r) : "v"(lo), "v"(hi)); return r; }
DI float bf_lo(unsigned w) { return __uint_as_float(w << 16); }
DI float bf_hi(unsigned w) { return __uint_as_float(w & 0xffff0000u); }
DI float fast_rcp(float x) { return __builtin_amdgcn_rcpf(x); }
DI float fexp(float x) { return __builtin_amdgcn_exp2f(x * 1.44269504089f); }
DI float sigmoidf_(float x) { return fast_rcp(1.0f + fexp(-x)); }
DI float siluf_(float x) { return x * sigmoidf_(x); }
DI u32x2 pack4(const f32x4 a) { u32x2 w; w.x = cvt_pk_bf16(a[0], a[1]); w.y = cvt_pk_bf16(a[2], a[3]); return w; }
DI f32x4 unpack4(const u32x2 w) { return (f32x4){bf_lo(w.x), bf_hi(w.x), bf_lo(w.y), bf_hi(w.y)}; }
DI float wave_sum(float v) {
#pragma unroll
  for (int o = 1; o < 64; o <<= 1) v += __shfl_xor(v, o);
  return v;
}

namespace pg8 {
constexpr int BM = 256, BK = 64, HALF = 128, HTB = HALF * BK * 2, STAGE_BYTES = 8 * HTB, NXCD = 8, WGM = 8;
DI int lds_byte(int r, int c) { const int st = (r >> 4) * 2 + (c >> 5), rr = r & 15, cc = c & 31, ob = rr * 64 + cc * 2; return st * 1024 + (ob ^ (((ob >> 9) & 1) << 5)); }
DI void stage_rc(int b, int& R, int& C) { const int st = b / 1024, sb = b % 1024, swz = sb ^ (((sb >> 9) & 1) << 5); R = (st >> 1) * 16 + swz / 64; C = (st & 1) * 32 + (swz % 64) / 2; }
DI int perm32(int rho) { const int n = rho >> 4, i = rho & 15; return 8 * (i >> 2) + 4 * n + (i & 3); }
struct Unit { int pm, pn; };
struct Gemm { const bf16_t* A; const bf16_t* Bt; int M, N, K; };
struct StaticOrder {
  int nM, nN, nwg, G, c;
  DI void init(int M, int N, int G_, int c_) { nM = M / BM; nN = N / BM; nwg = nM * nN; G = G_; c = c_; }
  DI bool next(int i, Unit& u) const {
    const long L = (long)i * G + c; if (L >= nwg) return false;
    int wgid = (int)L; { const int q = nwg / NXCD, r = nwg % NXCD, xcd = wgid % NXCD, off = wgid / NXCD; wgid = (xcd < r ? xcd * (q + 1) : r * (q + 1) + (xcd - r) * q) + off; }
    const int nig = WGM * nN, gid = wgid / nig, fm = gid * WGM, gsz = (nM - fm) < WGM ? (nM - fm) : WGM;
    u.pm = fm + ((wgid % nig) % gsz); u.pn = (wgid % nig) / gsz; return true;
  }
};

template <class Epi>
DI void gemm_phase(LAS unsigned char* lds, const Gemm g, const StaticOrder& S, const Epi& E) {
  int tid = threadIdx.x; asm volatile("" : "+v"(tid));
  const int wid = __builtin_amdgcn_readfirstlane(tid >> 6), lane = tid & 63, wr = wid >> 2, wc = wid & 3, fr = lane & 15, fq = lane >> 4;
  const int K = g.K, nt = K / BK;
  unsigned voffA[2], voffB[2];
#pragma unroll
  for (int i = 0; i < 2; ++i) { int R, C; stage_rc(tid * 16 + i * 8192, R, C); const int Rb = (R & ~31) + perm32(R & 31);
    voffA[i] = (unsigned)(R * K + C) * 2u; voffB[i] = (unsigned)(Rb * K + C) * 2u; }
  const size_t kstep = (size_t)(BK * 2);
  const size_t hstep = (size_t)HALF * K * 2;
  const size_t tstep = 2 * hstep;
  const unsigned ldsw = (unsigned)wid * 1024u;
  const int aoff = lds_byte(wr * 64 + fr, fq * 8), boff = lds_byte(wc * 32 + fr, fq * 8);
#define PG8_SA(b, h) (((b) * 2 + (h)) * HTB)
#define PG8_SB(b, h) ((4 + (b) * 2 + (h)) * HTB)
#define PG8_STAGE(bufoff, gbase, voff) do { _Pragma("unroll") for (int _i = 0; _i < 2; ++_i) \
        __builtin_amdgcn_global_load_lds((const unsigned*)((const char*)(gbase) + (voff)[_i]), (LAS unsigned*)(lds + (bufoff) + ldsw + _i * 8192), 16, 0, 0); } while (0)
#define PG8_LDA(dst, b, h) do { _Pragma("unroll") for (int m = 0; m < 4; ++m) _Pragma("unroll") for (int k = 0; k < 2; ++k) dst[m][k] = *(const LAS bf16x8*)(lds + PG8_SA(b, h) + aoff + m * 2048 + k * 1024); } while (0)
#define PG8_LDB(dst, b, h) do { _Pragma("unroll") for (int n = 0; n < 2; ++n) _Pragma("unroll") for (int k = 0; k < 2; ++k) dst[n][k] = *(const LAS bf16x8*)(lds + PG8_SB(b, h) + boff + n * 2048 + k * 1024); } while (0)
#define PG8_MMA(ai, bj, At, Bt) do { __builtin_amdgcn_s_setprio(1); _Pragma("unroll") for (int m = 0; m < 4; ++m) _Pragma("unroll") for (int n = 0; n < 2; ++n) _Pragma("unroll") for (int k = 0; k < 2; ++k) \
        acc[ai][bj][m][n] = __builtin_amdgcn_mfma_f32_16x16x32_bf16(Bt[n][k], At[m][k], acc[ai][bj][m][n], 0, 0, 0); __builtin_amdgcn_s_setprio(0); } while (0)
#define PG8_WAIT_V(n) asm volatile("s_waitcnt vmcnt(" #n ")" ::: "memory")
#define PG8_WAIT_L(n) asm volatile("s_waitcnt lgkmcnt(" #n ")" ::: "memory")
#define PG8_BAR __builtin_amdgcn_s_barrier()
#define PG8_SCHED __builtin_amdgcn_sched_barrier(0)
  Unit cur, nxt; int ui = 0;
  if (!S.next(0, cur)) return;
  f32x4 acc[2][2][4][2];
  float zf = 0.f; asm volatile("" : "+v"(zf));
#pragma unroll
  for (int a = 0; a < 2; ++a)
#pragma unroll
    for (int b = 0; b < 2; ++b)
#pragma unroll
      for (int m = 0; m < 4; ++m)
#pragma unroll
        for (int n = 0; n < 2; ++n) acc[a][b][m][n] = (f32x4){zf, zf, zf, zf};
  bf16x8 At[4][2], B0[2][2], B1[2][2];
  const char* cA = (const char*)g.A + (size_t)cur.pm * tstep; const char* cB = (const char*)g.Bt + (size_t)cur.pn * tstep;
  PG8_STAGE(PG8_SB(0, 0), cB, voffB); PG8_STAGE(PG8_SB(0, 1), cB + hstep, voffB); PG8_STAGE(PG8_SA(0, 0), cA, voffA); PG8_STAGE(PG8_SA(0, 1), cA + hstep, voffA);
  if (wr == 1) PG8_BAR;
  PG8_WAIT_V(2); PG8_BAR;
  PG8_STAGE(PG8_SB(1, 0), cB + kstep, voffB); PG8_STAGE(PG8_SA(1, 0), cA + kstep, voffA); PG8_STAGE(PG8_SB(1, 1), cB + hstep + kstep, voffB);
  PG8_WAIT_V(6); PG8_BAR;
  for (;;) {
    const bool has_next = S.next(ui + 1, nxt);
    const char* nA = has_next ? (const char*)g.A + (size_t)nxt.pm * tstep : cA; const char* nB = has_next ? (const char*)g.Bt + (size_t)nxt.pn * tstep : cB;
    for (int t = 0; t < nt; t += 2) {
      const bool last = (t == nt - 2);
      const char* a1 = cA + (size_t)(t + 1) * kstep;
      const char* a2 = last ? nA : cA + (size_t)(t + 2) * kstep; const char* b2 = last ? nB : cB + (size_t)(t + 2) * kstep;
      const char* a3 = a2 + kstep; const char* b3 = b2 + kstep;
      PG8_LDB(B0, 0, 0); PG8_LDB(B1, 0, 1); PG8_SCHED; PG8_LDA(At, 0, 0); PG8_STAGE(PG8_SA(1, 1), a1 + hstep, voffA);
      PG8_WAIT_V(8); PG8_WAIT_L(0); PG8_BAR; PG8_MMA(0, 0, At, B0); PG8_MMA(0, 1, At, B1); PG8_BAR; PG8_SCHED;
      PG8_LDA(At, 0, 1); PG8_STAGE(PG8_SB(0, 0), b2, voffB); PG8_STAGE(PG8_SB(0, 1), b2 + hstep, voffB); PG8_STAGE(PG8_SA(0, 0), a2, voffA);
      PG8_WAIT_V(8); PG8_WAIT_L(0); PG8_BAR; PG8_MMA(1, 0, At, B0); PG8_MMA(1, 1, At, B1); PG8_BAR; PG8_SCHED;
      PG8_LDB(B0, 1, 0); PG8_LDB(B1, 1, 1); PG8_SCHED; PG8_LDA(At, 1, 0); PG8_STAGE(PG8_SA(0, 1), a2 + hstep, voffA);
      PG8_WAIT_V(8); PG8_WAIT_L(0); PG8_BAR; PG8_MMA(0, 0, At, B0); PG8_MMA(0, 1, At, B1); PG8_BAR; PG8_SCHED;
      PG8_LDA(At, 1, 1); PG8_STAGE(PG8_SB(1, 0), b3, voffB); PG8_STAGE(PG8_SB(1, 1), b3 + hstep, voffB); PG8_STAGE(PG8_SA(1, 0), a3, voffA);
      PG8_WAIT_V(8); PG8_WAIT_L(0); PG8_BAR; PG8_MMA(1, 0, At, B0); PG8_MMA(1, 1, At, B1); PG8_BAR; PG8_SCHED;
    }
    if (wr == 0) PG8_BAR;
    E(acc, cur, wr, wc, fr, fq);
    if (!has_next) break;
#pragma unroll
    for (int a = 0; a < 2; ++a)
#pragma unroll
      for (int b = 0; b < 2; ++b)
#pragma unroll
        for (int m = 0; m < 4; ++m)
#pragma unroll
          for (int n = 0; n < 2; ++n) acc[a][b][m][n] = (f32x4){zf, zf, zf, zf};
    cur = nxt; cA = nA; cB = nB; ++ui;
    if (wr == 1) PG8_BAR;
  }
  PG8_WAIT_V(0);
  PG8_BAR;
#undef PG8_SA
#undef PG8_SB
#undef PG8_STAGE
#undef PG8_LDA
#undef PG8_LDB
#undef PG8_MMA
#undef PG8_WAIT_V
#undef PG8_WAIT_L
#undef PG8_BAR
#undef PG8_SCHED
}
}

typedef f32x4 AccT[2][2][4][2];
DI u32x4 pack8(const f32x4 a, const f32x4 b) { u32x4 w; w.x = cvt_pk_bf16(a[0], a[1]); w.y = cvt_pk_bf16(a[2], a[3]); w.z = cvt_pk_bf16(b[0], b[1]); w.w = cvt_pk_bf16(b[2], b[3]); return w; }

struct EpiIn {
  const float* rowsq; bf16_t *u0, *q, *k, *v, *sg; const float *cs, *sn;
  DI void operator()(const AccT& acc, const pg8::Unit& u, int wr, int wc, int fr, int fq) const {
    const int row0 = u.pm * 256 + wr * 64 + fr, c8 = wc * 32 + 8 * fq, pn = u.pn;
    float rs[2][4];
#pragma unroll
    for (int ai = 0; ai < 2; ++ai)
#pragma unroll
      for (int m = 0; m < 4; ++m) rs[ai][m] = rowsq[row0 + ai * 128 + m * 16];
    __builtin_amdgcn_sched_barrier(0);
    if (pn >= 4 && pn < 8) {
      const int which = (pn - 4) >> 1, head = 2 * ((pn - 4) & 1) + (c8 >> 6), dd = c8 & 63;
      const float lg = which ? __log2f(1.0f - __builtin_amdgcn_exp2f(-5.0f - (float)head)) : 0.f;
#pragma unroll
      for (int ai = 0; ai < 2; ++ai)
#pragma unroll
      for (int mp = 0; mp < 2; ++mp) {
        f32x4 tc[2][2], ts[2][2];
#pragma unroll
        for (int m2 = 0; m2 < 2; ++m2) { const int pos = (row0 + ai * 128 + (2 * mp + m2) * 16) & (SEQ - 1);
          tc[m2][0] = *(const f32x4*)(cs + pos * 64 + dd); tc[m2][1] = *(const f32x4*)(cs + pos * 64 + dd + 4); ts[m2][0] = *(const f32x4*)(sn + pos * 64 + dd); ts[m2][1] = *(const f32x4*)(sn + pos * 64 + dd + 4); }
        __builtin_amdgcn_sched_barrier(0);
#pragma unroll
        for (int m2 = 0; m2 < 2; ++m2) {
          const int m = 2 * mp + m2;
          const int r = row0 + ai * 128 + m * 16;
          const float rstd = rsqrtf(rs[ai][m] * (1.0f / DM) + EPS);
          float sc = rstd;
          if (which) sc *= 0.08838834764831845f * __builtin_amdgcn_exp2f(lg * (float)(63 - (r & 63)));
          const f32x4 a0 = acc[ai][0][m][0] * sc, a1 = acc[ai][0][m][1] * sc, b0 = acc[ai][1][m][0] * sc, b1 = acc[ai][1][m][1] * sc;
          const f32x4 o1a = a0 * tc[m2][0] - b0 * ts[m2][0], o1b = a1 * tc[m2][1] - b1 * ts[m2][1], o2a = a0 * ts[m2][0] + b0 * tc[m2][0], o2b = a1 * ts[m2][1] + b1 * tc[m2][1];
          bf16_t* dst = (which ? k : q) + (size_t)r * 512 + head * 128 + dd;
          *(u32x4*)dst = pack8(o1a, o1b); *(u32x4*)(dst + 64) = pack8(o2a, o2b);
        }
        __builtin_amdgcn_sched_barrier(0);
      }
      return;
    }
#pragma unroll
    for (int ai = 0; ai < 2; ++ai)
#pragma unroll
      for (int m = 0; m < 4; ++m) {
        const int r = row0 + ai * 128 + m * 16;
        const float rstd = rsqrtf(rs[ai][m] * (1.0f / DM) + EPS);
        const f32x4 a0 = acc[ai][0][m][0] * rstd, a1 = acc[ai][0][m][1] * rstd, b0 = acc[ai][1][m][0] * rstd, b1 = acc[ai][1][m][1] * rstd;
        if (pn < 4) {
          f32x4 o0, o1;
#pragma unroll
          for (int j = 0; j < 4; ++j) { o0[j] = a0[j] * sigmoidf_(b0[j]); o1[j] = a1[j] * sigmoidf_(b1[j]); }
          *(u32x4*)(u0 + (size_t)r * 512 + pn * 128 + c8) = pack8(o0, o1);
        } else if (pn < 10) {
          bf16_t* dst = v + (size_t)r * 512 + (pn - 8) * 256 + c8;
          *(u32x4*)dst = pack8(a0, a1); *(u32x4*)(dst + 128) = pack8(b0, b1);
        } else {
          f32x4 o0, o1, o2, o3;
#pragma unroll
          for (int j = 0; j < 4; ++j) { o0[j] = siluf_(a0[j]); o1[j] = siluf_(a1[j]); o2[j] = siluf_(b0[j]); o3[j] = siluf_(b1[j]); }
          bf16_t* dst = sg + (size_t)r * 512 + (pn - 10) * 256 + c8;
          *(u32x4*)dst = pack8(o0, o1); *(u32x4*)(dst + 128) = pack8(o2, o3);
        }
      }
  }
};
DI float lo_scale_dn(unsigned hf_bits) { unsigned e = (hf_bits >> 23) & 0xffu; e = e < 16u ? 16u : e; return __uint_as_float((e - 15u) << 23); }
DI float lo_scale_up(unsigned hf_bits) { unsigned e = (hf_bits >> 23) & 0xffu; e = e < 16u ? 16u : e; return __uint_as_float((269u - e) << 23); }
DI void lo_decode8(const u32x4 h, const u32x2 q, f32x4& b0, f32x4& b1) {
  const unsigned hw[4] = {h.x, h.y, h.z, h.w}; float o[8];
#pragma unroll
  for (int t = 0; t < 4; ++t) {
    const unsigned fl = hw[t] << 16, fh = hw[t] & 0xffff0000u; const unsigned qq = t < 2 ? q.x : q.y; const int sh = (t & 1) * 16;
    const int ql = (int)(qq << (24 - sh)) >> 24, qh = (int)(qq << (16 - sh)) >> 24;
    o[2 * t] = __uint_as_float(fl) + (float)ql * lo_scale_dn(fl); o[2 * t + 1] = __uint_as_float(fh) + (float)qh * lo_scale_dn(fh);
  }
  b0 = (f32x4){o[0], o[1], o[2], o[3]}; b1 = (f32x4){o[4], o[5], o[6], o[7]};
}
DI void lo_encode8(const f32x4 x0, const f32x4 x1, u32x4& h, u32x2& q) {
  h = pack8(x0, x1);
  const unsigned hw[4] = {h.x, h.y, h.z, h.w}; const float xs[8] = {x0[0], x0[1], x0[2], x0[3], x1[0], x1[1], x1[2], x1[3]}; unsigned qb[2] = {0u, 0u};
#pragma unroll
  for (int t = 0; t < 4; ++t) {
    const unsigned fl = hw[t] << 16, fh = hw[t] & 0xffff0000u;
    int ql = (int)__builtin_rintf((xs[2 * t] - __uint_as_float(fl)) * lo_scale_up(fl)), qh = (int)__builtin_rintf((xs[2 * t + 1] - __uint_as_float(fh)) * lo_scale_up(fh));
    ql = ql < -127 ? -127 : (ql > 127 ? 127 : ql); qh = qh < -127 ? -127 : (qh > 127 ? 127 : qh);
    qb[t >> 1] |= (((unsigned)ql & 0xffu) | (((unsigned)qh & 0xffu) << 8)) << ((t & 1) * 16);
  }
  q.x = qb[0]; q.y = qb[1];
}
DI float sumsq8(const f32x4 x0, const f32x4 x1) { return (x0[0] * x0[0] + x0[1] * x0[1]) + (x0[2] * x0[2] + x0[3] * x0[3]) + (x1[0] * x1[0] + x1[1] * x1[1]) + (x1[2] * x1[2] + x1[3] * x1[3]); }
struct EpiRes {
  const float* base; float* out; bf16_t* hi; unsigned char* lo; float* rowsq_next; int in_f32, out_f32; const float* fg; unsigned* cnt;
  DI void operator()(const AccT& acc, const pg8::Unit& u, int wr, int wc, int fr, int fq) const {
    const int row0 = u.pm * 256 + wr * 64 + fr, col0 = u.pn * 256 + wc * 32 + 8 * fq;
    if (out_f32) {
      AccT& xa = const_cast<AccT&>(acc);
      { u32x4 lh[2][2]; u32x2 lq[2][2];
#define FIN_LOAD(st) do { _Pragma("unroll") for (int bj = 0; bj < 2; ++bj) { const unsigned off = (unsigned)((row0 + ((st) >> 2) * 128 + ((st) & 3) * 16) * DM + col0 + bj * 128); \
        lh[(st) & 1][bj] = *(const u32x4*)(hi + off); lq[(st) & 1][bj] = *(const u32x2*)(lo + off); } } while (0)
        FIN_LOAD(0);
#pragma unroll
        for (int st = 0; st < 8; ++st) {
          if (st < 7) FIN_LOAD(st + 1);
          __builtin_amdgcn_sched_barrier(0);
          const int ai = st >> 2, m = st & 3; const int r = row0 + ai * 128 + m * 16; float ss = 0.f;
#pragma unroll
          for (int bj = 0; bj < 2; ++bj) { f32x4 b0, b1; lo_decode8(lh[st & 1][bj], lq[st & 1][bj], b0, b1);
            xa[ai][bj][m][0] += b0; xa[ai][bj][m][1] += b1; ss += sumsq8(xa[ai][bj][m][0], xa[ai][bj][m][1]); }
          ss += __shfl_xor(ss, 16); ss += __shfl_xor(ss, 32);
          if (fq == 0) atomicAdd(rowsq_next + r, ss);
          __builtin_amdgcn_sched_barrier(0);
        }
#undef FIN_LOAD
      }
      asm volatile("s_waitcnt vmcnt(0)" ::: "memory");
      unsigned* pc = cnt + u.pm * 2 + wr;
      if (fr == 0 && fq == 0) __hip_atomic_fetch_add(pc, 1u, __ATOMIC_RELAXED, __HIP_MEMORY_SCOPE_AGENT);
      { unsigned sp = 0;
        while ((unsigned)__builtin_amdgcn_readfirstlane(__hip_atomic_load(pc, __ATOMIC_RELAXED, __HIP_MEMORY_SCOPE_AGENT)) < 16u) { __builtin_amdgcn_s_sleep(2); if (++sp > (1u << 22)) break; } }
      __builtin_amdgcn_fence(__ATOMIC_ACQUIRE, "agent");
      float rsv[2][4];
#pragma unroll
      for (int ai = 0; ai < 2; ++ai)
#pragma unroll
        for (int m = 0; m < 4; ++m) rsv[ai][m] = rsqrtf(__hip_atomic_load(rowsq_next + row0 + ai * 128 + m * 16, __ATOMIC_RELAXED, __HIP_MEMORY_SCOPE_AGENT) * (1.0f / DM) + EPS);
#pragma unroll
      for (int bj = 0; bj < 2; ++bj) {
        const f32x4 ga = *(const f32x4*)(fg + col0 + bj * 128), gb = *(const f32x4*)(fg + col0 + bj * 128 + 4);
        __builtin_amdgcn_sched_barrier(0);
#pragma unroll
        for (int ai = 0; ai < 2; ++ai)
#pragma unroll
          for (int m = 0; m < 4; ++m) { const unsigned off = (unsigned)((row0 + ai * 128 + m * 16) * DM + col0 + bj * 128);
            *(f32x4*)(out + off) = xa[ai][bj][m][0] * rsv[ai][m] * ga; *(f32x4*)(out + off + 4) = xa[ai][bj][m][1] * rsv[ai][m] * gb; }
        __builtin_amdgcn_sched_barrier(0);
      }
      return;
    }
    if (in_f32) {
      f32x4 lf[2][2][2];
#define INF_LOAD(st) do { _Pragma("unroll") for (int bj = 0; bj < 2; ++bj) { const unsigned off = (unsigned)((row0 + ((st) >> 2) * 128 + ((st) & 3) * 16) * DM + col0 + bj * 128); \
      lf[(st) & 1][bj][0] = *(const f32x4*)(base + off); lf[(st) & 1][bj][1] = *(const f32x4*)(base + off + 4); } } while (0)
      INF_LOAD(0);
#pragma unroll
      for (int st = 0; st < 8; ++st) {
        if (st < 7) INF_LOAD(st + 1);
        __builtin_amdgcn_sched_barrier(0);
        const int ai = st >> 2, m = st & 3; const int r = row0 + ai * 128 + m * 16; float ss = 0.f;
#pragma unroll
        for (int bj = 0; bj < 2; ++bj) { const unsigned off = (unsigned)(r * DM + col0 + bj * 128);
          const f32x4 x0 = lf[st & 1][bj][0] + acc[ai][bj][m][0], x1 = lf[st & 1][bj][1] + acc[ai][bj][m][1];
          u32x4 hw; u32x2 qw; lo_encode8(x0, x1, hw, qw); *(u32x4*)(hi + off) = hw; *(u32x2*)(lo + off) = qw; ss += sumsq8(x0, x1); }
        ss += __shfl_xor(ss, 16); ss += __shfl_xor(ss, 32);
        if (fq == 0) atomicAdd(rowsq_next + r, ss);
        __builtin_amdgcn_sched_barrier(0);
      }
#undef INF_LOAD
      return;
    }
    u32x4 lh[2][2]; u32x2 lq[2][2];
#define RES_LOAD(st) do { _Pragma("unroll") for (int bj = 0; bj < 2; ++bj) { const unsigned off = (unsigned)((row0 + ((st) >> 2) * 128 + ((st) & 3) * 16) * DM + col0 + bj * 128); \
      lh[(st) & 1][bj] = *(const u32x4*)(hi + off); lq[(st) & 1][bj] = *(const u32x2*)(lo + off); } } while (0)
#define RES_COMP(st) do { const int ai = (st) >> 2, m = (st) & 3; const int r = row0 + ai * 128 + m * 16; float ss = 0.f; _Pragma("unroll") for (int bj = 0; bj < 2; ++bj) { const unsigned off = (unsigned)(r * DM + col0 + bj * 128); \
      f32x4 b0, b1; lo_decode8(lh[(st) & 1][bj], lq[(st) & 1][bj], b0, b1); const f32x4 x0 = b0 + acc[ai][bj][m][0], x1 = b1 + acc[ai][bj][m][1]; u32x4 hw; u32x2 qw; lo_encode8(x0, x1, hw, qw); \
      *(u32x4*)(hi + off) = hw; *(u32x2*)(lo + off) = qw; ss += sumsq8(x0, x1); } \
      ss += __shfl_xor(ss, 16); ss += __shfl_xor(ss, 32); if (fq == 0) atomicAdd(rowsq_next + r, ss); } while (0)
    RES_LOAD(0);
#pragma unroll
    for (int st = 0; st < 8; ++st) {
      if (st < 7) RES_LOAD(st + 1);
      __builtin_amdgcn_sched_barrier(0);
      RES_COMP(st);
      __builtin_amdgcn_sched_barrier(0);
    }
#undef RES_LOAD
#undef RES_COMP
  }
};
struct EpiGU {
  const float* rowsq; bf16_t* hid;
  DI void operator()(const AccT& acc, const pg8::Unit& u, int wr, int wc, int fr, int fq) const {
    const int row0 = u.pm * 256 + wr * 64 + fr, c8 = wc * 32 + 8 * fq;
    float rs[2][4];
#pragma unroll
    for (int ai = 0; ai < 2; ++ai)
#pragma unroll
      for (int m = 0; m < 4; ++m) rs[ai][m] = rowsq[row0 + ai * 128 + m * 16];
    __builtin_amdgcn_sched_barrier(0);
#pragma unroll
    for (int ai = 0; ai < 2; ++ai)
#pragma unroll
      for (int m = 0; m < 4; ++m) {
        const int r = row0 + ai * 128 + m * 16;
        const float rstd = rsqrtf(rs[ai][m] * (1.0f / DM) + EPS);
        const f32x4 a0 = acc[ai][0][m][0] * rstd, a1 = acc[ai][0][m][1] * rstd, b0 = acc[ai][1][m][0] * rstd, b1 = acc[ai][1][m][1] * rstd;
        f32x4 o0, o1;
#pragma unroll
        for (int j = 0; j < 4; ++j) { o0[j] = siluf_(a0[j]) * b0[j]; o1[j] = siluf_(a1[j]) * b1[j]; }
        __builtin_nontemporal_store(pack8(o0, o1), (u32x4*)(hid + (size_t)r * DFF + u.pn * 128 + c8));
      }
  }
};

DI int map_win(int n) {
  if (n < 512) return 256 * (n >> 7) + (n & 127);
  if (n < 1024) { const int nn = n - 512; return 256 * (nn >> 7) + 128 + (nn & 127); }
  if (n < 2048) { const int which = (n - 1024) >> 9, nn = (n - 1024) & 511, head = nn >> 7, d = nn & 127; return 256 * (4 + 2 * which + (head >> 1)) + 128 * (d >> 6) + 64 * (head & 1) + (d & 63); }
  return n;
}
template <int MODE>
DI void transpose_item(const float* W, int K, int N, const float* gk, bf16_t* WT, LAS float* scr, int item, int lane) {
  const int nblk = N / 64, kb = item / nblk, nb = item % nblk, k0 = 64 * kb, n0 = 64 * nb;
  const float* src = W + (size_t)k0 * N + n0 + lane;
  float w[64];
#pragma unroll
  for (int i = 0; i < 64; ++i) w[i] = src[(size_t)i * N];
  if (gk) {
#pragma unroll
    for (int i = 0; i < 64; ++i) w[i] *= gk[k0 + i];
  }
#pragma unroll
  for (int i = 0; i < 64; ++i) scr[i * 65 + lane] = w[i];
  asm volatile("s_waitcnt lgkmcnt(0)" ::: "memory");
  const int c = lane & 7;
#pragma unroll
  for (int j = 0; j < 8; ++j) { const int n = (lane >> 3) + 8 * j; const LAS float* s = scr + (8 * c) * 65 + n;
    u32x4 o; o.x = cvt_pk_bf16(s[0 * 65], s[1 * 65]); o.y = cvt_pk_bf16(s[2 * 65], s[3 * 65]); o.z = cvt_pk_bf16(s[4 * 65], s[5 * 65]); o.w = cvt_pk_bf16(s[6 * 65], s[7 * 65]);
    const int ng = n0 + n;
    const int nm = MODE == 0 ? ng : MODE == 1 ? map_win(ng) : (256 * (ng >> 7) + (MODE == 3 ? 128 : 0) + (ng & 127));
    *(u32x4*)(WT + (size_t)nm * K + k0 + 8 * c) = o; }
  asm volatile("s_waitcnt lgkmcnt(0)" ::: "memory");
}
DI void phase_prologue(const Params& p, LAS unsigned char* lds) {
  int tid = threadIdx.x; asm volatile("" : "+v"(tid));
  const int lane = tid & 63, wave = tid >> 6;
  const int gw = blockIdx.x * 8 + wave, NGW = gridDim.x * 8;
  LAS float* scr = (LAS float*)(lds + wave * 16640);
  unsigned char* ws = p.ws;
  constexpr int I_IN = 16 * 48, I_OUT = 16 * 16, I_G = 16 * 44, I_DN = 44 * 16, I_LAYER = I_IN + I_OUT + 2 * I_G + I_DN;
  for (int it = gw; it < NLAYER * I_LAYER; it += NGW) {
    const int l = it / I_LAYER; int r = it % I_LAYER;
    if (r < I_IN) { transpose_item<1>(p.in[2] + (size_t)l * DM * INW, DM, INW, p.in[1] + l * DM, (bf16_t*)(ws + OFF_WIN + l * SZ_WIN), scr, r, lane); continue; } r -= I_IN;
    if (r < I_OUT) { transpose_item<0>(p.in[8] + (size_t)l * DM * DM, DM, DM, nullptr, (bf16_t*)(ws + OFF_WOUT + l * SZ_WOUT), scr, r, lane); continue; } r -= I_OUT;
    if (r < I_G) { transpose_item<2>(p.in[10] + (size_t)l * DM * DFF, DM, DFF, p.in[9] + l * DM, (bf16_t*)(ws + OFF_WGU + l * SZ_WGU), scr, r, lane); continue; } r -= I_G;
    if (r < I_G) { transpose_item<3>(p.in[11] + (size_t)l * DM * DFF, DM, DFF, p.in[9] + l * DM, (bf16_t*)(ws + OFF_WGU + l * SZ_WGU), scr, r, lane); continue; } r -= I_G;
    transpose_item<0>(p.in[12] + (size_t)l * DFF * DM, DFF, DM, nullptr, (bf16_t*)(ws + OFF_WDN + l * SZ_WDN), scr, r, lane);
  }
  const float* x = p.in[0]; bf16_t* xb = (bf16_t*)(ws + OFF_XB); float* rowsq = (float*)(ws + OFF_ROWSQ);
  for (int row = gw; row < MTOK; row += 2 * NGW) {
    const int row2 = row + NGW;
    const f32x4* xr = (const f32x4*)(x + (size_t)row * DM) + lane; u32x2* o = (u32x2*)(xb + (size_t)row * DM) + lane;
    const bool has2 = row2 < MTOK;
    const f32x4* xr2 = (const f32x4*)(x + (size_t)(has2 ? row2 : row) * DM) + lane; u32x2* o2 = (u32x2*)(xb + (size_t)(has2 ? row2 : row) * DM) + lane;
    f32x4 v[4], v2[4];
#pragma unroll
    for (int j = 0; j < 4; ++j) { v[j] = xr[64 * j]; v2[j] = xr2[64 * j]; }
    float s = 0.f, s2 = 0.f;
#pragma unroll
    for (int j = 0; j < 4; ++j) { s += (v[j][0] * v[j][0] + v[j][1] * v[j][1]) + (v[j][2] * v[j][2] + v[j][3] * v[j][3]); u32x2 w; w.x = cvt_pk_bf16(v[j][0], v[j][1]); w.y = cvt_pk_bf16(v[j][2], v[j][3]); o[64 * j] = w;
      s2 += (v2[j][0] * v2[j][0] + v2[j][1] * v2[j][1]) + (v2[j][2] * v2[j][2] + v2[j][3] * v2[j][3]); u32x2 w2; w2.x = cvt_pk_bf16(v2[j][0], v2[j][1]); w2.y = cvt_pk_bf16(v2[j][2], v2[j][3]); o2[64 * j] = w2; }
    s = wave_sum(s); s2 = wave_sum(s2);
    if (lane == 0) { rowsq[row] = s; if (has2) rowsq[row2] = s2; }
  }
  const int gt = blockIdx.x * 512 + tid, NGT = gridDim.x * 512;
  for (int i = gt; i < 8 * MTOK; i += NGT) rowsq[MTOK + i] = 0.f;
  float* cs = (float*)(ws + OFF_COS); float* sn = (float*)(ws + OFF_SIN);
  for (int i = gt; i < SEQ * 64; i += NGT) {
    const int pos = i >> 6, fi = i & 63;
    const double freq = exp(-(double)fi * (9.210340371976184 / 64.0));
    const double t = (double)pos * freq * 0.6366197723675814;
    const double qd = rint(t); const double r = (t - qd) * 1.5707963267948966; const double r2 = r * r;
    const double sv = r * (1.0 + r2 * (-1.0 / 6 + r2 * (1.0 / 120 + r2 * (-1.0 / 5040 + r2 * (1.0 / 362880 + r2 * (-1.0 / 39916800))))));
    const double cv = 1.0 + r2 * (-0.5 + r2 * (1.0 / 24 + r2 * (-1.0 / 720 + r2 * (1.0 / 40320 + r2 * (-1.0 / 3628800 + r2 * (1.0 / 479001600))))));
    const int qi = ((int)qd) & 3;
    const double s_ = qi == 0 ? sv : qi == 1 ? cv : qi == 2 ? -sv : -cv;
    const double c_ = qi == 0 ? cv : qi == 1 ? -sv : qi == 2 ? -cv : sv;
    cs[i] = (float)c_; sn[i] = (float)s_;
  }
}

DI void conv_load(const bf16_t* U0, int item, int tid, u32x4 (&pf)[8]) {
  const int b = item >> 8, t0 = (item & 255) * 32;
#pragma unroll
  for (int i = 0; i < 8; ++i) { const int id = tid + 512 * i, row = id >> 6, ch = id & 63, tok = t0 - 30 + row; const bool ok = (id < 62 * 64) && (tok >= 0);
    const u32x4 v = *(const u32x4*)(U0 + ((size_t)(b * SEQ + (ok ? tok : 0))) * 512 + ch * 8);
    pf[i] = ok ? v : (u32x4){0u, 0u, 0u, 0u}; }
}
DI void conv_items(const Params& p, int l, int first, int stride, int limit, LAS unsigned char* lds) {
  int tid = threadIdx.x; asm volatile("" : "+v"(tid));
  const int lane = tid & 63, wave = tid >> 6;
  const bf16_t* U0 = (const bf16_t*)(p.ws + OFF_U0); bf16_t* MIX = (bf16_t*)(p.ws + OFF_MIX);
  LAS unsigned char* in = lds;
  LAS float* st = (LAS float*)(lds + 63488);
  if (first >= limit) return;
  u32x4 pf[8];
  conv_load(U0, first, tid, pf);
  const int cs_ = tid >> 8, cp_ = tid & 255;
  f32x2 wv[CONVK];
  { const float* cw = p.in[3] + (size_t)l * CONVK * CWID + 2 * cp_;
#pragma unroll
    for (int j = 0; j < CONVK; ++j) wv[j] = *(const f32x2*)(cw + j * CWID); }
  const f32x2 bb = *(const f32x2*)(p.in[4] + l * CWID + 2 * cp_);
  const f32x4 g0 = *(const f32x4*)(p.in[5] + l * CWID + lane * 8), g1 = *(const f32x4*)(p.in[5] + l * CWID + lane * 8 + 4), b0 = *(const f32x4*)(p.in[6] + l * CWID + lane * 8), b1 = *(const f32x4*)(p.in[6] + l * CWID + lane * 8 + 4);
  for (int item = first; item < limit; item += stride) {
  const int b = item >> 8, t0 = (item & 255) * 32;
#pragma unroll
  for (int i = 0; i < 8; ++i) { const int id = tid + 512 * i; if (id < 62 * 64) *(LAS u32x4*)(in + (id >> 6) * 1024 + (id & 63) * 16) = pf[i]; }
  __syncthreads();
  if (item + stride < limit) conv_load(U0, item + stride, tid, pf);
  {
    const int s = cs_, cp = cp_;
    f32x2 av[16];
#pragma unroll
    for (int o = 0; o < 16; ++o) av[o] = bb;
#pragma unroll
    for (int ii = 0; ii < 46; ++ii) {
      const unsigned xw = *(const LAS unsigned*)(in + (16 * s + ii) * 1024 + cp * 4); const f32x2 xv = (f32x2){bf_lo(xw), bf_hi(xw)};
#pragma unroll
      for (int o = 0; o < 16; ++o) { const int j = ii - o; if (j >= 0 && j < CONVK) av[o] = __builtin_elementwise_fma(wv[j], xv, av[o]); }
    }
#pragma unroll
    for (int o = 0; o < 16; ++o) *(LAS f32x2*)(st + (16 * s + o) * 516 + 2 * cp) = av[o];
  }
  __syncthreads();
  {
#pragma unroll
    for (int tt = 0; tt < 4; ++tt) {
      const int oo = wave * 4 + tt;
      const LAS float* r = st + oo * 516 + lane * 8;
      const f32x4 A = *(const LAS f32x4*)r, B = *(const LAS f32x4*)(r + 4);
      float s1 = (A[0] + A[1]) + (A[2] + A[3]) + (B[0] + B[1]) + (B[2] + B[3]);
      float s2 = (A[0] * A[0] + A[1] * A[1]) + (A[2] * A[2] + A[3] * A[3]) + (B[0] * B[0] + B[1] * B[1]) + (B[2] * B[2] + B[3] * B[3]);
#pragma unroll
      for (int o = 1; o < 64; o <<= 1) { s1 += __shfl_xor(s1, o); s2 += __shfl_xor(s2, o); }
      const float mean = s1 * (1.0f / CWID);
      const float var = fmaxf(s2 * (1.0f / CWID) - mean * mean, 0.f);
      const f32x4 dA = A - mean, dB = B - mean;
      const float rstd = rsqrtf(var + EPS);
      f32x4 y0 = dA * rstd * g0 + b0, y1 = dB * rstd * g1 + b1;
#pragma unroll
      for (int j = 0; j < 4; ++j) { y0[j] = siluf_(y0[j]); y1[j] = siluf_(y1[j]); }
      *(u32x4*)(MIX + ((size_t)(b * SEQ + t0 + oo)) * DM + lane * 8) = pack8(y0, y1);
    }
  }
  __syncthreads();
  }
}

DI bf16x8 tr_pair(const LAS unsigned char* base, int row_stride) {
  const s16x4 lo = __builtin_amdgcn_ds_read_tr16_b64_v4i16((LAS s16x4*)base);
  const s16x4 hi = __builtin_amdgcn_ds_read_tr16_b64_v4i16((LAS s16x4*)(base + 4 * row_stride));
  return __builtin_shufflevector(lo, hi, 0, 1, 2, 3, 4, 5, 6, 7);
}
template <int PASS>
DI void ret_item(const Params& p, int l, int item, LAS unsigned char* lds) {
  constexpr int RS = 272, PS = 144;
  int tid = threadIdx.x; asm volatile("" : "+v"(tid));
  const int lane = tid & 63, wave = __builtin_amdgcn_readfirstlane(tid >> 6), g = lane >> 4, c16 = lane & 15, tq = c16 >> 2, tp = c16 & 3;
  const int b = item >> 6, h = (item >> 4) & 3, seg = item & 15;
  const size_t tokbase = (size_t)b * SEQ + seg * 512;
  const float log2g = __log2f(1.0f - __builtin_amdgcn_exp2f(-5.0f - (float)h));
  const bf16_t* Qg = (const bf16_t*)(p.ws + OFF_Q) + h * 128; const bf16_t* Kg = (const bf16_t*)(p.ws + OFF_K) + h * 128; const bf16_t* Vg = (const bf16_t*)(p.ws + OFF_V) + h * 128;
  const bf16_t* SGg = (const bf16_t*)(p.ws + OFF_SG) + h * 128; bf16_t* MIX = (bf16_t*)(p.ws + OFF_MIX) + 512 + h * 128;
  u32x2* Lb = (u32x2*)(p.ws + OFF_L);
  LAS unsigned char* Qs = lds; LAS unsigned char* Ks = lds + 17408; LAS unsigned char* Vs = lds + 34816; LAS unsigned char* Ps = lds + 52224; LAS unsigned char* Ss = lds + 61440;
  LAS float* stats = (LAS float*)(lds + 96256);
  u32x4 rq[2], rk[2], rv[2];
  f32x4 Sacc[8];
#define RET_LOAD(n) do { _Pragma("unroll") for (int i_ = 0; i_ < 2; ++i_) { const int id_ = tid + 512 * i_, j_ = id_ >> 4, ch_ = id_ & 15; const size_t o_ = (tokbase + (n) * 64 + j_) * 512 + ch_ * 8; \
      rk[i_] = *(const u32x4*)(Kg + o_); rv[i_] = *(const u32x4*)(Vg + o_); if (PASS == 2) rq[i_] = *(const u32x4*)(Qg + o_); } } while (0)
#define RET_STORE() do { _Pragma("unroll") for (int i_ = 0; i_ < 2; ++i_) { const int id_ = tid + 512 * i_, j_ = id_ >> 4, ch_ = id_ & 15; \
      *(LAS u32x4*)(Ks + j_ * RS + ch_ * 16) = rk[i_]; *(LAS u32x4*)(Vs + j_ * RS + ch_ * 16) = rv[i_]; if (PASS == 2) *(LAS u32x4*)(Qs + j_ * RS + ch_ * 16) = rq[i_]; } } while (0)
#define RET_WRITE_S() do { _Pragma("unroll") for (int dt_ = 0; dt_ < 8; ++dt_) { u32x2 w_; w_.x = cvt_pk_bf16(Sacc[dt_][0], Sacc[dt_][1]); w_.y = cvt_pk_bf16(Sacc[dt_][2], Sacc[dt_][3]); \
      *(LAS u32x2*)(Ss + (16 * dt_ + c16) * RS + (16 * wave + 4 * g) * 2) = w_; } } while (0)
  RET_LOAD(0);
  const int it_c = wave & 3, eh_c = wave >> 2, i_c = 16 * it_c + c16;
  u32x2 sg_cur[4], sg_nxt[4]; f32x4 gnv[4];
  if (PASS == 2) {
#pragma unroll
    for (int et = 0; et < 4; ++et) { const int e0 = 64 * eh_c + 16 * et + 4 * g; gnv[et] = *(const f32x4*)(p.in[7] + l * RWID + h * 128 + e0); sg_nxt[et] = *(const u32x2*)(SGg + (tokbase + i_c) * 512 + e0); }
  }
#pragma unroll
  for (int dt = 0; dt < 8; ++dt) Sacc[dt] = (f32x4){0.f, 0.f, 0.f, 0.f};
  if (PASS == 2) {
    const u32x2* Lp = Lb + (size_t)item * 4096 + (wave * 8) * 64 + lane;
#pragma unroll
    for (int dt = 0; dt < 8; ++dt) Sacc[dt] = unpack4(Lp[dt * 64]);
  }
  RET_STORE();
  if (PASS == 2) RET_WRITE_S();
  __syncthreads();
  const float g64 = __builtin_amdgcn_exp2f(log2g * 64.0f);
  float dB[2][4]; float gi_c = 0.f;
  if (PASS == 2) {
    const int jt_ = wave >> 1, it0_ = 2 * (wave & 1);
#pragma unroll
    for (int t = 0; t < 2; ++t)
#pragma unroll
      for (int r = 0; r < 4; ++r) { const int i = 16 * (it0_ + t) + c16, j = 16 * jt_ + 4 * g + r; dB[t][r] = __builtin_amdgcn_exp2f(log2g * (float)((i > j ? i - j : j - i) + j - 63)); }
    gi_c = __builtin_amdgcn_exp2f(log2g * (float)(i_c + 1));
  }
  for (int n = 0; n < 8; ++n) {
    if (n < 7) RET_LOAD(n + 1);
    if (PASS == 2) {
#pragma unroll
      for (int et = 0; et < 4; ++et) { sg_cur[et] = sg_nxt[et]; if (n < 7) sg_nxt[et] = *(const u32x2*)(SGg + (tokbase + (n + 1) * 64 + i_c) * 512 + 64 * eh_c + 16 * et + 4 * g); }
      {
        const int jt = wave >> 1, it0 = 2 * (wave & 1);
        f32x4 sacc[2] = {(f32x4){0.f, 0.f, 0.f, 0.f}, (f32x4){0.f, 0.f, 0.f, 0.f}};
        bf16x8 ka[4], qb[2][4];
#pragma unroll
        for (int ks = 0; ks < 4; ++ks) { ka[ks] = *(const LAS bf16x8*)(Ks + (16 * jt + c16) * RS + (32 * ks + 8 * g) * 2);
#pragma unroll
          for (int t = 0; t < 2; ++t) qb[t][ks] = *(const LAS bf16x8*)(Qs + (16 * (it0 + t) + c16) * RS + (32 * ks + 8 * g) * 2); }
        __builtin_amdgcn_sched_barrier(0);
#pragma unroll
        for (int ks = 0; ks < 4; ++ks)
#pragma unroll
          for (int t = 0; t < 2; ++t) sacc[t] = __builtin_amdgcn_mfma_f32_16x16x32_bf16(ka[ks], qb[t][ks], sacc[t], 0, 0, 0);
        __builtin_amdgcn_sched_barrier(0);
#pragma unroll
        for (int t = 0; t < 2; ++t) { const int i = 16 * (it0 + t) + c16; float pv[4];
#pragma unroll
          for (int r = 0; r < 4; ++r) pv[r] = sacc[t][r] * dB[t][r];
          u32x2 w_; w_.x = cvt_pk_bf16(pv[0], pv[1]); w_.y = cvt_pk_bf16(pv[2], pv[3]);
          *(LAS u32x2*)(Ps + i * PS + (16 * jt + 4 * g) * 2) = w_; }
      }
    }
    f32x4 accI[4], accX[4];
    const int it = wave & 3, eh = wave >> 2, i = 16 * it + c16;
    if (PASS == 2) {
#pragma unroll
      for (int et = 0; et < 4; ++et) { accI[et] = (f32x4){0.f, 0.f, 0.f, 0.f}; accX[et] = (f32x4){0.f, 0.f, 0.f, 0.f}; }
#pragma unroll
      for (int kh = 0; kh < 2; ++kh) {
        bf16x8 bq[2], as_[2][4];
#pragma unroll
        for (int k2 = 0; k2 < 2; ++k2) { const int ks = 2 * kh + k2; bq[k2] = *(const LAS bf16x8*)(Qs + i * RS + (32 * ks + 8 * g) * 2);
#pragma unroll
          for (int et = 0; et < 4; ++et) as_[k2][et] = tr_pair(Ss + (32 * ks + 8 * g + tq) * RS + (64 * eh + 16 * et + 4 * tp) * 2, RS); }
        __builtin_amdgcn_sched_barrier(0);
#pragma unroll
        for (int k2 = 0; k2 < 2; ++k2)
#pragma unroll
          for (int et = 0; et < 4; ++et) accX[et] = __builtin_amdgcn_mfma_f32_16x16x32_bf16(as_[k2][et], bq[k2], accX[et], 0, 0, 0);
        __builtin_amdgcn_sched_barrier(0);
      }
    }
    if (PASS == 1 || n < 7) {
#pragma unroll
      for (int dt = 0; dt < 8; ++dt) Sacc[dt] *= g64;
#pragma unroll
      for (int ks = 0; ks < 2; ++ks) {
        bf16x8 bk[8];
        const bf16x8 a = tr_pair(Vs + (32 * ks + 8 * g + tq) * RS + (16 * wave + 4 * tp) * 2, RS);
#pragma unroll
        for (int dt = 0; dt < 8; ++dt) bk[dt] = tr_pair(Ks + (32 * ks + 8 * g + tq) * RS + (16 * dt + 4 * tp) * 2, RS);
        __builtin_amdgcn_sched_barrier(0);
#pragma unroll
        for (int dt = 0; dt < 8; ++dt) Sacc[dt] = __builtin_amdgcn_mfma_f32_16x16x32_bf16(a, bk[dt], Sacc[dt], 0, 0, 0);
        __builtin_amdgcn_sched_barrier(0);
      }
    }
    __syncthreads();
    if (PASS == 2) {
      {
        bf16x8 bp[2], av[2][4];
#pragma unroll
        for (int ks = 0; ks < 2; ++ks) { bp[ks] = *(const LAS bf16x8*)(Ps + i * PS + (32 * ks + 8 * g) * 2);
#pragma unroll
          for (int et = 0; et < 4; ++et) av[ks][et] = tr_pair(Vs + (32 * ks + 8 * g + tq) * RS + (64 * eh + 16 * et + 4 * tp) * 2, RS); }
        __builtin_amdgcn_sched_barrier(0);
#pragma unroll
        for (int ks = 0; ks < 2; ++ks)
#pragma unroll
          for (int et = 0; et < 4; ++et) accI[et] = __builtin_amdgcn_mfma_f32_16x16x32_bf16(av[ks][et], bp[ks], accI[et], 0, 0, 0);
        __builtin_amdgcn_sched_barrier(0);
      }
      const float gi = gi_c;
      float s1 = 0.f, s2 = 0.f;
#pragma unroll
      for (int et = 0; et < 4; ++et) { accI[et] += accX[et] * gi;
        s1 += (accI[et][0] + accI[et][1]) + (accI[et][2] + accI[et][3]);
        s2 += (accI[et][0] * accI[et][0] + accI[et][1] * accI[et][1]) + (accI[et][2] * accI[et][2] + accI[et][3] * accI[et][3]); }
      s1 += __shfl_xor(s1, 16); s1 += __shfl_xor(s1, 32); s2 += __shfl_xor(s2, 16); s2 += __shfl_xor(s2, 32);
      if (g == 0) { stats[(eh * 64 + i) * 2] = s1; stats[(eh * 64 + i) * 2 + 1] = s2; }
      __syncthreads();
      const float t1 = stats[i * 2] + stats[(64 + i) * 2], t2 = stats[i * 2 + 1] + stats[(64 + i) * 2 + 1];
      const float mean = t1 * (1.0f / 128.0f), var = fmaxf(t2 * (1.0f / 128.0f) - mean * mean, 0.f), rstd = rsqrtf(var + EPS);
      const size_t tok = tokbase + n * 64 + i;
#pragma unroll
      for (int et = 0; et < 4; ++et) { const int e0 = 64 * eh + 16 * et + 4 * g;
        const f32x4 gn = gnv[et]; const u32x2 sgw = sg_cur[et];
        const float v0 = (accI[et][0] - mean) * rstd * gn[0] * bf_lo(sgw.x), v1 = (accI[et][1] - mean) * rstd * gn[1] * bf_hi(sgw.x);
        const float v2 = (accI[et][2] - mean) * rstd * gn[2] * bf_lo(sgw.y), v3 = (accI[et][3] - mean) * rstd * gn[3] * bf_hi(sgw.y);
        u32x2 w_; w_.x = cvt_pk_bf16(v0, v1); w_.y = cvt_pk_bf16(v2, v3);
        *(u32x2*)(MIX + tok * DM + e0) = w_; }
    }
    if (n < 7) { RET_STORE(); if (PASS == 2) RET_WRITE_S(); }
    __syncthreads();
  }
  if (PASS == 1) {
    u32x2* Lp = Lb + (size_t)item * 4096 + (wave * 8) * 64 + lane;
#pragma unroll
    for (int dt = 0; dt < 8; ++dt) Lp[dt * 64] = pack4(Sacc[dt]);
  }
#undef RET_LOAD
#undef RET_STORE
#undef RET_WRITE_S
}


DI void ret_scan(const Params& p) {
  u32x2* Lb = (u32x2*)(p.ws + OFF_L);
  int tid_ = threadIdx.x; asm volatile("" : "+v"(tid_));
  const int gt = blockIdx.x * 512 + tid_, NGT = gridDim.x * 512;
  for (int idx = gt; idx < 16 * 4096; idx += NGT) {
    const int bh = idx >> 12, e = idx & 4095, h = bh & 3;
    u32x2* base = Lb + (size_t)bh * 16 * 4096 + e;
    const float g512 = __builtin_amdgcn_exp2f(__log2f(1.0f - __builtin_amdgcn_exp2f(-5.0f - (float)h)) * 512.0f);
    u32x2 v[15];
#pragma unroll
    for (int s_ = 0; s_ < 15; ++s_) v[s_] = base[(size_t)s_ * 4096];
    float z_ = 0.f; asm volatile("" : "+v"(z_));
    f32x4 a = (f32x4){z_, z_, z_, z_};
    base[0] = pack4(a);
#pragma unroll
    for (int s_ = 0; s_ < 15; ++s_) { a = a * g512 + unpack4(v[s_]); base[(size_t)(s_ + 1) * 4096] = pack4(a); }
  }
}

#define XB_TMO      128
#define XB_XCNT(j)  (256  + 64 * (j))
#define XB_XSUB(j)  (1280 + 64 * (j))
#define XB_XGEN(j)  (2304 + 64 * (j))
#define XB_TOP      3328
#define XB_TOPGEN   3392
#define XCD_BAR_WORDS 3456
#define XB_SPIN_CAP (1u << 18)
DI unsigned xb_ld(unsigned* p)              { return __hip_atomic_load(p, __ATOMIC_RELAXED, __HIP_MEMORY_SCOPE_AGENT); }
DI unsigned xb_add(unsigned* p, unsigned v) { return __hip_atomic_fetch_add(p, v, __ATOMIC_RELAXED, __HIP_MEMORY_SCOPE_AGENT); }
DI unsigned xb_xcc_id() { return (unsigned)__builtin_amdgcn_s_getreg((3 << 11) | 20) & 0xFu; }
#define XB_SPIN(cond, bar) do { unsigned _sp = 0; while (cond) { __builtin_amdgcn_s_sleep(1); \
    if ((++_sp & 255u) == 0u) { if (xb_ld(&(bar)[XB_TMO])) break; if (_sp > XB_SPIN_CAP) { atomicAdd(&(bar)[XB_TMO], 1u); break; } } } } while (0)
struct XcdBarrier { unsigned* bar; unsigned x; volatile LAS unsigned* st; };
DI XcdBarrier xcd_barrier_post(unsigned* bar, volatile LAS unsigned* st) {
  XcdBarrier b; b.bar = bar; b.x = xb_xcc_id(); b.st = st;
  if (threadIdx.x == 0) (void)xb_add(&bar[XB_XCNT(b.x)], 1u);
  return b;
}
DI void xcd_barrier_complete(unsigned* bar, unsigned x, unsigned& nloc, unsigned& nx) {
  const unsigned G = gridDim.x * gridDim.y * gridDim.z;
  unsigned sum, cnt, mine, sp = 0u;
  for (;;) {
    sum = 0u; cnt = 0u; mine = 0u;
#pragma unroll
    for (unsigned j = 0; j < 16; ++j) { const unsigned c = xb_ld(&bar[XB_XCNT(j)]); sum += c; cnt += (c > 0u) ? 1u : 0u; mine = (j == x) ? c : mine; }
    if (sum == G) break;
    __builtin_amdgcn_s_sleep(1);
    if ((++sp & 255u) == 0u) { if (xb_ld(&bar[XB_TMO])) break; if (sp > XB_SPIN_CAP) { atomicAdd(&bar[XB_TMO], 1u); break; } }
  }
  nloc = mine > 0u ? mine : 1u; nx = cnt > 0u ? cnt : 1u;
}
DI void xcd_barrier(const XcdBarrier& b) {
  asm volatile("s_waitcnt vmcnt(0)" ::: "memory");
  __syncthreads();
  if (threadIdx.x == 0) {
    unsigned* bar = b.bar;
    __builtin_amdgcn_s_waitcnt(0);
    unsigned nloc = b.st[0], nx = b.st[1];
    if (nloc == 0u) { xcd_barrier_complete(bar, b.x, nloc, nx); b.st[0] = nloc; b.st[1] = nx; }
    const unsigned old = xb_add(&bar[XB_XSUB(b.x)], 1u);
    const unsigned gen = old / nloc;
    if (old + 1u == (gen + 1u) * nloc) {
      __builtin_amdgcn_fence(__ATOMIC_RELEASE, "agent");
      asm volatile("s_waitcnt vmcnt(0)" ::: "memory");
      const unsigned og = xb_add(&bar[XB_TOP], 1u);
      const unsigned tg = og / nx;
      if (og + 1u == (tg + 1u) * nx) xb_add(&bar[XB_TOPGEN], 1u);
      else XB_SPIN(xb_ld(&bar[XB_TOPGEN]) == tg, bar);
      __builtin_amdgcn_fence(__ATOMIC_ACQUIRE, "agent");
      xb_add(&bar[XB_XGEN(b.x)], 1u);
      asm volatile("s_waitcnt vmcnt(0)" ::: "memory");
    } else {
      XB_SPIN(xb_ld(&bar[XB_XGEN(b.x)]) == gen, bar);
      __builtin_amdgcn_fence(__ATOMIC_ACQUIRE, "agent");
      asm volatile("s_waitcnt vmcnt(0)" ::: "memory");
    }
  }
  __syncthreads();
}

extern __shared__ __attribute__((aligned(16))) unsigned char smem_dyn[];

__global__ void __launch_bounds__(512) fwd_mega(Params p) {
  cg::grid_group grid = cg::this_grid();
  LAS unsigned char* lds = (LAS unsigned char*)smem_dyn;
  unsigned char* ws = p.ws;
  float* rowsq = (float*)(ws + OFF_ROWSQ);
  bf16_t* XB = (bf16_t*)(ws + OFF_XB); unsigned char* XLO = ws + OFF_XLO;
  const int G = gridDim.x, c = blockIdx.x;
  volatile LAS unsigned* bst = (volatile LAS unsigned*)(lds + 133120);
  if (threadIdx.x == 0) { bst[0] = 0u; bst[1] = 0u; }
  __syncthreads();
  const XcdBarrier xbar = xcd_barrier_post((unsigned*)(ws + OFF_BAR), bst);
#define GSYNC() xcd_barrier(xbar)

  phase_prologue(p, lds);
  grid.sync();

  for (int l = 0; l < NLAYER; ++l) {
    { pg8::Gemm gm{XB, (const bf16_t*)(ws + OFF_WIN + l * SZ_WIN), MTOK, INW, DM};
      pg8::StaticOrder so; so.init(MTOK, INW, G, c);
      EpiIn e{rowsq + (size_t)(2 * l) * MTOK, (bf16_t*)(ws + OFF_U0), (bf16_t*)(ws + OFF_Q), (bf16_t*)(ws + OFF_K), (bf16_t*)(ws + OFF_V), (bf16_t*)(ws + OFF_SG), (const float*)(ws + OFF_COS), (const float*)(ws + OFF_SIN)};
      pg8::gemm_phase(lds, gm, so, e); }
    GSYNC();
    for (int it = c; it < 256; it += G) ret_item<1>(p, l, it, lds);
    if (G == 256) { const int x_ = c & 7, j_ = c >> 3; conv_items(p, l, 128 * x_ + j_, 32, 128 * x_ + 128, lds); }
    else conv_items(p, l, c, G, 1024, lds);
    GSYNC();
    ret_scan(p);
    GSYNC();
    for (int it = c; it < 256; it += G) ret_item<2>(p, l, it, lds);
    GSYNC();
    { pg8::Gemm gm{(const bf16_t*)(ws + OFF_MIX), (const bf16_t*)(ws + OFF_WOUT + l * SZ_WOUT), MTOK, DM, DM};
      pg8::StaticOrder so; so.init(MTOK, DM, G, c);
      EpiRes e{p.in[0], p.out, XB, XLO, rowsq + (size_t)(2 * l + 1) * MTOK, l == 0, 0, p.in[13], (unsigned*)(ws + OFF_BAR) + 3584};
      pg8::gemm_phase(lds, gm, so, e);
 }
    GSYNC();
    { pg8::Gemm gm{XB, (const bf16_t*)(ws + OFF_WGU + l * SZ_WGU), MTOK, 2 * DFF, DM};
      pg8::StaticOrder so; so.init(MTOK, 2 * DFF, G, c);
      EpiGU e{rowsq + (size_t)(2 * l + 1) * MTOK, (bf16_t*)(ws + OFF_HID)};
      pg8::gemm_phase(lds, gm, so, e);
 }
    GSYNC();
    { pg8::Gemm gm{(const bf16_t*)(ws + OFF_HID), (const bf16_t*)(ws + OFF_WDN + l * SZ_WDN), MTOK, DM, DFF};
      pg8::StaticOrder so; so.init(MTOK, DM, G, c);
      EpiRes e{p.in[0], p.out, XB, XLO, rowsq + (size_t)(2 * l + 2) * MTOK, 0, l == NLAYER - 1, p.in[13], (unsigned*)(ws + OFF_BAR) + 3584};
      pg8::gemm_phase(lds, gm, so, e);
 }
    if (l < NLAYER - 1) GSYNC();
  }
}

extern "C" void kernel_launch(void* const* d_in, const int* in_sizes, int n_in, void* d_out, int out_size, void* d_ws, size_t ws_size, hipStream_t stream) {
  static int grid_blocks = 0;
  if (!grid_blocks) {
    int dev = 0, cus = 0, per_cu = 0;
    (void)hipGetDevice(&dev);
    (void)hipDeviceGetAttribute(&cus, hipDeviceAttributeMultiprocessorCount, dev);
    (void)hipFuncSetAttribute((const void*)fwd_mega, hipFuncAttributeMaxDynamicSharedMemorySize, LDS_BYTES);
    (void)hipOccupancyMaxActiveBlocksPerMultiprocessor(&per_cu, (const void*)fwd_mega, 512, LDS_BYTES);
    if (n_in != 14 || out_size != MTOK * DM || ws_size < WS_END) { fprintf(stderr, "kernel_launch: unexpected shapes (n_in %d out %d ws %zu need %zu)\n", n_in, out_size, ws_size, (size_t)WS_END); grid_blocks = -1; return; }
    grid_blocks = cus;
    fprintf(stderr, "kernel_launch: cus %d per_cu %d grid %d\n", cus, per_cu, grid_blocks);
  }
  if (grid_blocks < 0) return;
  (void)hipMemsetAsync((unsigned char*)d_ws + OFF_BAR, 0, 16384, stream);
  Params p{};
  for (int i = 0; i < 14; ++i) p.in[i] = (const float*)d_in[i];
  p.out = (float*)d_out; p.ws = (unsigned char*)d_ws;
  void* args[] = {&p};
  hipError_t e = hipLaunchCooperativeKernel((void*)fwd_mega, dim3(grid_blocks), dim3(512), args, LDS_BYTES, stream);
  if (e != hipSuccess) fprintf(stderr, "cooperative launch failed: %s (grid %d)\n", hipGetErrorString(e), grid_blocks);
}
```

```cpp
#include <hip/hip_runtime.h>
#include <hip/hip_cooperative_groups.h>
#include <cstdio>
namespace cg = cooperative_groups;

#define LAS __attribute__((address_space(3)))
#define DI __device__ __forceinline__
typedef unsigned short bf16_t;
typedef short bf16x8 __attribute__((ext_vector_type(8)));
typedef short s16x4 __attribute__((ext_vector_type(4)));
typedef float f32x4 __attribute__((ext_vector_type(4)));
typedef float f32x2 __attribute__((ext_vector_type(2)));
typedef unsigned u32x4 __attribute__((ext_vector_type(4)));
typedef unsigned u32x2 __attribute__((ext_vector_type(2)));

constexpr int MTOK = 32768, DM = 1024, SEQ = 8192, CWID = 512, RWID = 512, INW = 3072, DFF = 2816, NLAYER = 4, CONVK = 31;
constexpr float EPS = 1e-6f;
constexpr size_t SZ_WIN = (size_t)INW * DM * 2, SZ_WOUT = (size_t)DM * DM * 2, SZ_WGU = (size_t)2 * DFF * DM * 2, SZ_WDN = (size_t)DM * DFF * 2;
constexpr size_t OFF_WIN = 0, OFF_WOUT = OFF_WIN + NLAYER * SZ_WIN, OFF_WGU = OFF_WOUT + NLAYER * SZ_WOUT, OFF_WDN = OFF_WGU + NLAYER * SZ_WGU;
constexpr size_t OFF_XB = OFF_WDN + NLAYER * SZ_WDN;
constexpr size_t SZ_HALF = (size_t)MTOK * 512 * 2;
constexpr size_t OFF_ACT = OFF_XB + (size_t)MTOK * DM * 2;
constexpr size_t OFF_U0 = OFF_ACT, OFF_Q = OFF_U0 + SZ_HALF, OFF_K = OFF_Q + SZ_HALF, OFF_V = OFF_K + SZ_HALF, OFF_SG = OFF_V + SZ_HALF, OFF_MIX = OFF_SG + SZ_HALF;
constexpr size_t OFF_HID = OFF_ACT;
constexpr size_t OFF_ROWSQ = OFF_MIX + (size_t)MTOK * DM * 2;
constexpr size_t OFF_COS = OFF_ROWSQ + (size_t)9 * MTOK * 4, OFF_SIN = OFF_COS + (size_t)SEQ * 64 * 4;
constexpr size_t OFF_L = OFF_SIN + (size_t)SEQ * 64 * 4;
constexpr size_t OFF_BAR = OFF_L + (size_t)256 * 65536;
constexpr size_t OFF_XLO = OFF_BAR + 16384;
constexpr size_t WS_END = OFF_XLO + (size_t)MTOK * DM;
static_assert((size_t)MTOK * DFF * 2 <= OFF_ROWSQ - OFF_ACT, "HID alias too big");
constexpr int LDS_BYTES = 133120 + 256;

struct Params { const float* in[14]; float* out; unsigned char* ws; };

DI unsigned cvt_pk_bf16(float lo, float hi) { unsigned r; asm volatile("v_cvt_pk_bf16_f32 %0, %1, %2" : "=v"(r) : "v"(lo), "v"(hi)); return r; }
DI float bf_lo(unsigned w) { return __uint_as_float(w << 16); }
DI float bf_hi(unsigned w) { return __uint_as_float(w & 0xffff0000u); }
DI float fast_rcp(float x) { return __builtin_amdgcn_rcpf(x); }
DI float fexp(float x) { return __builtin_amdgcn_exp2f(x * 1.44269504089f); }
DI float sigmoidf_(float x) { return fast_rcp(1.0f + fexp(-x)); }
DI float siluf_(float x) { return x * sigmoidf_(x); }
DI float wave_sum(float v) {
#pragma unroll
  for (int o = 1; o < 64; o <<= 1) v += __shfl_xor(v, o);
  return v;
}

namespace pg8 {
constexpr int BM = 256, BK = 64, HALF = 128, HTB = HALF * BK * 2, STAGE_BYTES = 8 * HTB, NXCD = 8, WGM = 8;
DI int lds_byte(int r, int c) { const int st = (r >> 4) * 2 + (c >> 5), rr = r & 15, cc = c & 31, ob = rr * 64 + cc * 2; return st * 1024 + (ob ^ (((ob >> 9) & 1) << 5)); }
DI void stage_rc(int b, int& R, int& C) { const int st = b / 1024, sb = b % 1024, swz = sb ^ (((sb >> 9) & 1) << 5); R = (st >> 1) * 16 + swz / 64; C = (st & 1) * 32 + (swz % 64) / 2; }
DI int perm32(int rho) { const int n = rho >> 4, i = rho & 15; return 8 * (i >> 2) + 4 * n + (i & 3); }
struct Unit { int pm, pn; };
struct Gemm { const bf16_t* A; const bf16_t* Bt; int M, N, K; };
struct StaticOrder {
  int nM, nN, nwg, G, c;
  DI void init(int M, int N, int G_, int c_) { nM = M / BM; nN = N / BM; nwg = nM * nN; G = G_; c = c_; }
  DI bool next(int i, Unit& u) const {
    const long L = (long)i * G + c; if (L >= nwg) return false;
    int wgid = (int)L; { const int q = nwg / NXCD, r = nwg % NXCD, xcd = wgid % NXCD, off = wgid / NXCD; wgid = (xcd < r ? xcd * (q + 1) : r * (q + 1) + (xcd - r) * q) + off; }
    const int nig = WGM * nN, gid = wgid / nig, fm = gid * WGM, gsz = (nM - fm) < WGM ? (nM - fm) : WGM;
    u.pm = fm + ((wgid % nig) % gsz); u.pn = (wgid % nig) / gsz; return true;
  }
};

template <class Epi>
DI void gemm_phase(LAS unsigned char* lds, const Gemm g, const StaticOrder& S, const Epi& E) {
  int tid = threadIdx.x; asm volatile("" : "+v"(tid));
  const int wid = __builtin_amdgcn_readfirstlane(tid >> 6), lane = tid & 63, wr = wid >> 2, wc = wid & 3, fr = lane & 15, fq = lane >> 4;
  const int K = g.K, nt = K / BK;
  unsigned voffA[2], voffB[2];
#pragma unroll
  for (int i = 0; i < 2; ++i) { int R, C; stage_rc(tid * 16 + i * 8192, R, C); const int Rb = (R & ~31) + perm32(R & 31);
    voffA[i] = (unsigned)(R * K + C) * 2u; voffB[i] = (unsigned)(Rb * K + C) * 2u; }
  const size_t kstep = (size_t)(BK * 2);
  const size_t hstep = (size_t)HALF * K * 2;
  const size_t tstep = 2 * hstep;
  const unsigned ldsw = (unsigned)wid * 1024u;
  const int aoff = lds_byte(wr * 64 + fr, fq * 8), boff = lds_byte(wc * 32 + fr, fq * 8);
#define PG8_SA(b, h) (((b) * 2 + (h)) * HTB)
#define PG8_SB(b, h) ((4 + (b) * 2 + (h)) * HTB)
#define PG8_STAGE(bufoff, gbase, voff) do { _Pragma("unroll") for (int _i = 0; _i < 2; ++_i) \
        __builtin_amdgcn_global_load_lds((const unsigned*)((const char*)(gbase) + (voff)[_i]), (LAS unsigned*)(lds + (bufoff) + ldsw + _i * 8192), 16, 0, 0); } while (0)
#define PG8_LDA(dst, b, h) do { _Pragma("unroll") for (int m = 0; m < 4; ++m) _Pragma("unroll") for (int k = 0; k < 2; ++k) dst[m][k] = *(const LAS bf16x8*)(lds + PG8_SA(b, h) + aoff + m * 2048 + k * 1024); } while (0)
#define PG8_LDB(dst, b, h) do { _Pragma("unroll") for (int n = 0; n < 2; ++n) _Pragma("unroll") for (int k = 0; k < 2; ++k) dst[n][k] = *(const LAS bf16x8*)(lds + PG8_SB(b, h) + boff + n * 2048 + k * 1024); } while (0)
#define PG8_MMA(ai, bj, At, Bt) do { __builtin_amdgcn_s_setprio(1); _Pragma("unroll") for (int m = 0; m < 4; ++m) _Pragma("unroll") for (int n = 0; n < 2; ++n) _Pragma("unroll") for (int k = 0; k < 2; ++k) \
        acc[ai][bj][m][n] = __builtin_amdgcn_mfma_f32_16x16x32_bf16(Bt[n][k], At[m][k], acc[ai][bj][m][n], 0, 0, 0); __builtin_amdgcn_s_setprio(0); } while (0)
#define PG8_WAIT_V(n) asm volatile("s_waitcnt vmcnt(" #n ")" ::: "memory")
#define PG8_WAIT_L(n) asm volatile("s_waitcnt lgkmcnt(" #n ")" ::: "memory")
#define PG8_BAR __builtin_amdgcn_s_barrier()
#define PG8_SCHED __builtin_amdgcn_sched_barrier(0)
  Unit cur, nxt; int ui = 0;
  if (!S.next(0, cur)) return;
  f32x4 acc[2][2][4][2];
  float zf = 0.f; asm volatile("" : "+v"(zf));
#pragma unroll
  for (int a = 0; a < 2; ++a)
#pragma unroll
    for (int b = 0; b < 2; ++b)
#pragma unroll
      for (int m = 0; m < 4; ++m)
#pragma unroll
        for (int n = 0; n < 2; ++n) acc[a][b][m][n] = (f32x4){zf, zf, zf, zf};
  bf16x8 At[4][2], B0[2][2], B1[2][2];
  const char* cA = (const char*)g.A + (size_t)cur.pm * tstep; const char* cB = (const char*)g.Bt + (size_t)cur.pn * tstep;
  PG8_STAGE(PG8_SB(0, 0), cB, voffB); PG8_STAGE(PG8_SB(0, 1), cB + hstep, voffB); PG8_STAGE(PG8_SA(0, 0), cA, voffA); PG8_STAGE(PG8_SA(0, 1), cA + hstep, voffA);
  if (wr == 1) PG8_BAR;
  PG8_WAIT_V(2); PG8_BAR;
  PG8_STAGE(PG8_SB(1, 0), cB + kstep, voffB); PG8_STAGE(PG8_SA(1, 0), cA + kstep, voffA); PG8_STAGE(PG8_SB(1, 1), cB + hstep + kstep, voffB);
  PG8_WAIT_V(6); PG8_BAR;
  for (;;) {
    const bool has_next = S.next(ui + 1, nxt);
    const char* nA = has_next ? (const char*)g.A + (size_t)nxt.pm * tstep : cA; const char* nB = has_next ? (const char*)g.Bt + (size_t)nxt.pn * tstep : cB;
    for (int t = 0; t < nt; t += 2) {
      const bool last = (t == nt - 2);
      const char* a1 = cA + (size_t)(t + 1) * kstep;
      const char* a2 = last ? nA : cA + (size_t)(t + 2) * kstep; const char* b2 = last ? nB : cB + (size_t)(t + 2) * kstep;
      const char* a3 = a2 + kstep; const char* b3 = b2 + kstep;
      PG8_LDB(B0, 0, 0); PG8_LDB(B1, 0, 1); PG8_SCHED; PG8_LDA(At, 0, 0); PG8_STAGE(PG8_SA(1, 1), a1 + hstep, voffA);
      PG8_WAIT_V(8); PG8_WAIT_L(0); PG8_BAR; PG8_MMA(0, 0, At, B0); PG8_MMA(0, 1, At, B1); PG8_BAR; PG8_SCHED;
      PG8_LDA(At, 0, 1); PG8_STAGE(PG8_SB(0, 0), b2, voffB); PG8_STAGE(PG8_SB(0, 1), b2 + hstep, voffB); PG8_STAGE(PG8_SA(0, 0), a2, voffA);
      PG8_WAIT_V(8); PG8_WAIT_L(0); PG8_BAR; PG8_MMA(1, 0, At, B0); PG8_MMA(1, 1, At, B1); PG8_BAR; PG8_SCHED;
      PG8_LDB(B0, 1, 0); PG8_LDB(B1, 1, 1); PG8_SCHED; PG8_LDA(At, 1, 0); PG8_STAGE(PG8_SA(0, 1), a2 + hstep, voffA);
      PG8_WAIT_V(8); PG8_WAIT_L(0); PG8_BAR; PG8_MMA(0, 0, At, B0); PG8_MMA(0, 1, At, B1); PG8_BAR; PG8_SCHED;
      PG8_LDA(At, 1, 1); PG8_STAGE(PG8_SB(1, 0), b3, voffB); PG8_STAGE(PG8_SB(1, 1), b3 + hstep, voffB); PG8_STAGE(PG8_SA(1, 0), a3, voffA);
      PG8_WAIT_V(8); PG8_WAIT_L(0); PG8_BAR; PG8_MMA(1, 0, At, B0); PG8_MMA(1, 1, At, B1); PG8_BAR; PG8_SCHED;
    }
    if (wr == 0) PG8_BAR;
    E(acc, cur, wr, wc, fr, fq);
    if (!has_next) break;
#pragma unroll
    for (int a = 0; a < 2; ++a)
#pragma unroll
      for (int b = 0; b < 2; ++b)
#pragma unroll
        for (int m = 0; m < 4; ++m)
#pragma unroll
          for (int n = 0; n < 2; ++n) acc[a][b][m][n] = (f32x4){zf, zf, zf, zf};
    cur = nxt; cA = nA; cB = nB; ++ui;
    if (wr == 1) PG8_BAR;
  }
  PG8_WAIT_V(0);
  PG8_BAR;
#undef PG8_SA
#undef PG8_SB
#undef PG8_STAGE
#undef PG8_LDA
#undef PG8_LDB
#undef PG8_MMA
#undef PG8_WAIT_V
#undef PG8_WAIT_L
#undef PG8_BAR
#undef PG8_SCHED
}
}

typedef f32x4 AccT[2][2][4][2];
DI u32x4 pack8(const f32x4 a, const f32x4 b) { u32x4 w; w.x = cvt_pk_bf16(a[0], a[1]); w.y = cvt_pk_bf16(a[2], a[3]); w.z = cvt_pk_bf16(b[0], b[1]); w.w = cvt_pk_bf16(b[2], b[3]); return w; }


DI f32x4 sig_scaled(const f32x4 t, float c1) {
  const f32x4 z = t * c1; f32x4 e;
#pragma unroll
  for (int j = 0; j < 4; ++j) e[j] = __builtin_amdgcn_exp2f(z[j]);
  const f32x4 d = e + 1.0f; f32x4 q;
#pragma unroll
  for (int j = 0; j < 4; ++j) q[j] = __builtin_amdgcn_rcpf(d[j]);
  return q;
}
struct EpiIn {
  const float* rowsq; bf16_t *u0, *q, *k, *v, *sg; const float *cs, *sn;
  DI void operator()(const AccT& acc, const pg8::Unit& u, int wr, int wc, int fr, int fq) const {
    const int row0 = u.pm * 256 + wr * 64 + fr, c8 = wc * 32 + 8 * fq, pn = u.pn;
    float rs[2][4];
#pragma unroll
    for (int ai = 0; ai < 2; ++ai)
#pragma unroll
      for (int m = 0; m < 4; ++m) rs[ai][m] = rowsq[row0 + ai * 128 + m * 16];
    __builtin_amdgcn_sched_barrier(0);
    if (pn >= 4 && pn < 8) {
      const int which = (pn - 4) >> 1, head = 2 * ((pn - 4) & 1) + (c8 >> 6), dd = c8 & 63;
      const float lg = which ? __log2f(1.0f - __builtin_amdgcn_exp2f(-5.0f - (float)head)) : 0.f;
#pragma unroll
      for (int ai = 0; ai < 2; ++ai)
#pragma unroll
      for (int mp = 0; mp < 2; ++mp) {
        f32x4 tc[2][2], ts[2][2];
#pragma unroll
        for (int m2 = 0; m2 < 2; ++m2) { const int pos = (row0 + ai * 128 + (2 * mp + m2) * 16) & (SEQ - 1);
          tc[m2][0] = *(const f32x4*)(cs + pos * 64 + dd); tc[m2][1] = *(const f32x4*)(cs + pos * 64 + dd + 4); ts[m2][0] = *(const f32x4*)(sn + pos * 64 + dd); ts[m2][1] = *(const f32x4*)(sn + pos * 64 + dd + 4); }
        __builtin_amdgcn_sched_barrier(0);
#pragma unroll
        for (int m2 = 0; m2 < 2; ++m2) {
          const int m = 2 * mp + m2;
          const int r = row0 + ai * 128 + m * 16;
          const float rstd = rsqrtf(rs[ai][m] * (1.0f / DM) + EPS);
          float sc = rstd;
          if (which) sc *= 0.08838834764831845f * __builtin_amdgcn_exp2f(lg * (float)(63 - (r & 63)));
          const f32x4 a0 = acc[ai][0][m][0] * sc, a1 = acc[ai][0][m][1] * sc, b0 = acc[ai][1][m][0] * sc, b1 = acc[ai][1][m][1] * sc;
          const f32x4 o1a = a0 * tc[m2][0] - b0 * ts[m2][0], o1b = a1 * tc[m2][1] - b1 * ts[m2][1], o2a = a0 * ts[m2][0] + b0 * tc[m2][0], o2b = a1 * ts[m2][1] + b1 * tc[m2][1];
          bf16_t* dst = (which ? k : q) + (size_t)r * 512 + head * 128 + dd;
          *(u32x4*)dst = pack8(o1a, o1b); *(u32x4*)(dst + 64) = pack8(o2a, o2b);
        }
        __builtin_amdgcn_sched_barrier(0);
      }
      return;
    }
#pragma unroll
    for (int ai = 0; ai < 2; ++ai)
#pragma unroll
      for (int m = 0; m < 4; ++m) {
        const int r = row0 + ai * 128 + m * 16;
        const float rstd = rsqrtf(rs[ai][m] * (1.0f / DM) + EPS);
        const float c1 = rstd * -1.44269504089f;
        const f32x4 p0 = acc[ai][0][m][0], p1 = acc[ai][0][m][1], q0 = acc[ai][1][m][0], q1 = acc[ai][1][m][1];
        if (pn < 4) {
          const f32x4 o0 = p0 * (sig_scaled(q0, c1) * rstd), o1 = p1 * (sig_scaled(q1, c1) * rstd);
          *(u32x4*)(u0 + (size_t)r * 512 + pn * 128 + c8) = pack8(o0, o1);
        } else if (pn < 10) {
          bf16_t* dst = v + (size_t)r * 512 + (pn - 8) * 256 + c8;
          *(u32x4*)dst = pack8(p0 * rstd, p1 * rstd); *(u32x4*)(dst + 128) = pack8(q0 * rstd, q1 * rstd);
        } else {
          const f32x4 o0 = p0 * (sig_scaled(p0, c1) * rstd), o1 = p1 * (sig_scaled(p1, c1) * rstd), o2 = q0 * (sig_scaled(q0, c1) * rstd), o3 = q1 * (sig_scaled(q1, c1) * rstd);
          bf16_t* dst = sg + (size_t)r * 512 + (pn - 10) * 256 + c8;
          *(u32x4*)dst = pack8(o0, o1); *(u32x4*)(dst + 128) = pack8(o2, o3);
        }
      }
  }
};
DI float lo_scale_dn(unsigned hf_bits) { unsigned e = (hf_bits >> 23) & 0xffu; e = e < 16u ? 16u : e; return __uint_as_float((e - 15u) << 23); }
DI float lo_scale_up(unsigned hf_bits) { unsigned e = (hf_bits >> 23) & 0xffu; e = e < 16u ? 16u : e; return __uint_as_float((269u - e) << 23); }
DI void lo_decode8(const u32x4 h, const u32x2 q, f32x4& b0, f32x4& b1) {
  const unsigned hw[4] = {h.x, h.y, h.z, h.w}; float o[8];
#pragma unroll
  for (int t = 0; t < 4; ++t) {
    const unsigned fl = hw[t] << 16, fh = hw[t] & 0xffff0000u; const unsigned qq = t < 2 ? q.x : q.y; const int sh = (t & 1) * 16;
    const int ql = (int)(qq << (24 - sh)) >> 24, qh = (int)(qq << (16 - sh)) >> 24;
    o[2 * t] = __uint_as_float(fl) + (float)ql * lo_scale_dn(fl); o[2 * t + 1] = __uint_as_float(fh) + (float)qh * lo_scale_dn(fh);
  }
  b0 = (f32x4){o[0], o[1], o[2], o[3]}; b1 = (f32x4){o[4], o[5], o[6], o[7]};
}
DI void lo_encode8(const f32x4 x0, const f32x4 x1, u32x4& h, u32x2& q) {
  h = pack8(x0, x1);
  const unsigned hw[4] = {h.x, h.y, h.z, h.w}; const float xs[8] = {x0[0], x0[1], x0[2], x0[3], x1[0], x1[1], x1[2], x1[3]}; unsigned qb[2] = {0u, 0u};
#pragma unroll
  for (int t = 0; t < 4; ++t) {
    const unsigned fl = hw[t] << 16, fh = hw[t] & 0xffff0000u;
    int ql = (int)__builtin_rintf((xs[2 * t] - __uint_as_float(fl)) * lo_scale_up(fl)), qh = (int)__builtin_rintf((xs[2 * t + 1] - __uint_as_float(fh)) * lo_scale_up(fh));
    ql = ql < -127 ? -127 : (ql > 127 ? 127 : ql); qh = qh < -127 ? -127 : (qh > 127 ? 127 : qh);
    qb[t >> 1] |= (((unsigned)ql & 0xffu) | (((unsigned)qh & 0xffu) << 8)) << ((t & 1) * 16);
  }
  q.x = qb[0]; q.y = qb[1];
}
DI float sumsq8(const f32x4 x0, const f32x4 x1) { return (x0[0] * x0[0] + x0[1] * x0[1]) + (x0[2] * x0[2] + x0[3] * x0[3]) + (x1[0] * x1[0] + x1[1] * x1[1]) + (x1[2] * x1[2] + x1[3] * x1[3]); }
struct EpiRes {
  const float* base; float* out; bf16_t* hi; unsigned char* lo; float* rowsq_next; int in_f32, out_f32; const float* fg; unsigned* cnt;
  DI void operator()(const AccT& acc, const pg8::Unit& u, int wr, int wc, int fr, int fq) const {
    const int row0 = u.pm * 256 + wr * 64 + fr, col0 = u.pn * 256 + wc * 32 + 8 * fq;
    if (out_f32) {
      AccT& xa = const_cast<AccT&>(acc);
      { u32x4 lh[2][2]; u32x2 lq[2][2];
#define FIN_LOAD(st) do { _Pragma("unroll") for (int bj = 0; bj < 2; ++bj) { const unsigned off = (unsigned)((row0 + ((st) >> 2) * 128 + ((st) & 3) * 16) * DM + col0 + bj * 128); \
        lh[(st) & 1][bj] = *(const u32x4*)(hi + off); lq[(st) & 1][bj] = *(const u32x2*)(lo + off); } } while (0)
        FIN_LOAD(0);
#pragma unroll
        for (int st = 0; st < 8; ++st) {
          if (st < 7) FIN_LOAD(st + 1);
          __builtin_amdgcn_sched_barrier(0);
          const int ai = st >> 2, m = st & 3; const int r = row0 + ai * 128 + m * 16; float ss = 0.f;
#pragma unroll
          for (int bj = 0; bj < 2; ++bj) { f32x4 b0, b1; lo_decode8(lh[st & 1][bj], lq[st & 1][bj], b0, b1);
            xa[ai][bj][m][0] += b0; xa[ai][bj][m][1] += b1; ss += sumsq8(xa[ai][bj][m][0], xa[ai][bj][m][1]); }
          ss += __shfl_xor(ss, 16); ss += __shfl_xor(ss, 32);
          if (fq == 0) atomicAdd(rowsq_next + r, ss);
          __builtin_amdgcn_sched_barrier(0);
        }
#undef FIN_LOAD
      }
      asm volatile("s_waitcnt vmcnt(0)" ::: "memory");
      unsigned* pc = cnt + u.pm * 2 + wr;
      if (fr == 0 && fq == 0) __hip_atomic_fetch_add(pc, 1u, __ATOMIC_RELAXED, __HIP_MEMORY_SCOPE_AGENT);
      { unsigned sp = 0;
        while ((unsigned)__builtin_amdgcn_readfirstlane(__hip_atomic_load(pc, __ATOMIC_RELAXED, __HIP_MEMORY_SCOPE_AGENT)) < 16u) { __builtin_amdgcn_s_sleep(2); if (++sp > (1u << 22)) break; } }
      __builtin_amdgcn_fence(__ATOMIC_ACQUIRE, "agent");
      float rsv[2][4];
#pragma unroll
      for (int ai = 0; ai < 2; ++ai)
#pragma unroll
        for (int m = 0; m < 4; ++m) rsv[ai][m] = rsqrtf(__hip_atomic_load(rowsq_next + row0 + ai * 128 + m * 16, __ATOMIC_RELAXED, __HIP_MEMORY_SCOPE_AGENT) * (1.0f / DM) + EPS);
#pragma unroll
      for (int bj = 0; bj < 2; ++bj) {
        const f32x4 ga = *(const f32x4*)(fg + col0 + bj * 128), gb = *(const f32x4*)(fg + col0 + bj * 128 + 4);
        __builtin_amdgcn_sched_barrier(0);
#pragma unroll
        for (int ai = 0; ai < 2; ++ai)
#pragma unroll
          for (int m = 0; m < 4; ++m) { const unsigned off = (unsigned)((row0 + ai * 128 + m * 16) * DM + col0 + bj * 128);
            *(f32x4*)(out + off) = xa[ai][bj][m][0] * rsv[ai][m] * ga; *(f32x4*)(out + off + 4) = xa[ai][bj][m][1] * rsv[ai][m] * gb; }
        __builtin_amdgcn_sched_barrier(0);
      }
      return;
    }
    if (in_f32) {
      f32x4 lf[2][2][2];
#define INF_LOAD(st) do { _Pragma("unroll") for (int bj = 0; bj < 2; ++bj) { const unsigned off = (unsigned)((row0 + ((st) >> 2) * 128 + ((st) & 3) * 16) * DM + col0 + bj * 128); \
      lf[(st) & 1][bj][0] = *(const f32x4*)(base + off); lf[(st) & 1][bj][1] = *(const f32x4*)(base + off + 4); } } while (0)
      INF_LOAD(0);
#pragma unroll
      for (int st = 0; st < 8; ++st) {
        if (st < 7) INF_LOAD(st + 1);
        __builtin_amdgcn_sched_barrier(0);
        const int ai = st >> 2, m = st & 3; const int r = row0 + ai * 128 + m * 16; float ss = 0.f;
#pragma unroll
        for (int bj = 0; bj < 2; ++bj) { const unsigned off = (unsigned)(r * DM + col0 + bj * 128);
          const f32x4 x0 = lf[st & 1][bj][0] + acc[ai][bj][m][0], x1 = lf[st & 1][bj][1] + acc[ai][bj][m][1];
          u32x4 hw; u32x2 qw; lo_encode8(x0, x1, hw, qw); *(u32x4*)(hi + off) = hw; *(u32x2*)(lo + off) = qw; ss += sumsq8(x0, x1); }
        ss += __shfl_xor(ss, 16); ss += __shfl_xor(ss, 32);
        if (fq == 0) atomicAdd(rowsq_next + r, ss);
        __builtin_amdgcn_sched_barrier(0);
      }
#undef INF_LOAD
      return;
    }
    u32x4 lh[2][2]; u32x2 lq[2][2];
#define RES_LOAD(st) do { _Pragma("unroll") for (int bj = 0; bj < 2; ++bj) { const unsigned off = (unsigned)((row0 + ((st) >> 2) * 128 + ((st) & 3) * 16) * DM + col0 + bj * 128); \
      lh[(st) & 1][bj] = *(const u32x4*)(hi + off); lq[(st) & 1][bj] = *(const u32x2*)(lo + off); } } while (0)
#define RES_COMP(st) do { const int ai = (st) >> 2, m = (st) & 3; const int r = row0 + ai * 128 + m * 16; float ss = 0.f; _Pragma("unroll") for (int bj = 0; bj < 2; ++bj) { const unsigned off = (unsigned)(r * DM + col0 + bj * 128); \
      f32x4 b0, b1; lo_decode8(lh[(st) & 1][bj], lq[(st) & 1][bj], b0, b1); const f32x4 x0 = b0 + acc[ai][bj][m][0], x1 = b1 + acc[ai][bj][m][1]; u32x4 hw; u32x2 qw; lo_encode8(x0, x1, hw, qw); \
      *(u32x4*)(hi + off) = hw; *(u32x2*)(lo + off) = qw; ss += sumsq8(x0, x1); } \
      ss += __shfl_xor(ss, 16); ss += __shfl_xor(ss, 32); if (fq == 0) atomicAdd(rowsq_next + r, ss); } while (0)
    RES_LOAD(0);
#pragma unroll
    for (int st = 0; st < 8; ++st) {
      if (st < 7) RES_LOAD(st + 1);
      __builtin_amdgcn_sched_barrier(0);
      RES_COMP(st);
      __builtin_amdgcn_sched_barrier(0);
    }
#undef RES_LOAD
#undef RES_COMP
  }
};
struct EpiGU {
  const float* rowsq; bf16_t* hid;
  DI void operator()(const AccT& acc, const pg8::Unit& u, int wr, int wc, int fr, int fq) const {
    const int row0 = u.pm * 256 + wr * 64 + fr, c8 = wc * 32 + 8 * fq;
    float rs[2][4];
#pragma unroll
    for (int ai = 0; ai < 2; ++ai)
#pragma unroll
      for (int m = 0; m < 4; ++m) rs[ai][m] = rowsq[row0 + ai * 128 + m * 16];
    __builtin_amdgcn_sched_barrier(0);
#pragma unroll
    for (int ai = 0; ai < 2; ++ai)
#pragma unroll
      for (int m = 0; m < 4; ++m) {
        const int r = row0 + ai * 128 + m * 16;
        const float rstd = rsqrtf(rs[ai][m] * (1.0f / DM) + EPS);
        const float c1 = rstd * -1.44269504089f, r2 = rstd * rstd;
        const f32x4 g0 = acc[ai][0][m][0], g1 = acc[ai][0][m][1];
        const f32x4 o0 = (g0 * acc[ai][1][m][0]) * (sig_scaled(g0, c1) * r2), o1 = (g1 * acc[ai][1][m][1]) * (sig_scaled(g1, c1) * r2);
        __builtin_nontemporal_store(pack8(o0, o1), (u32x4*)(hid + (size_t)r * DFF + u.pn * 128 + c8));
      }
  }
};

DI int map_win(int n) {
  if (n < 512) return 256 * (n >> 7) + (n & 127);
  if (n < 1024) { const int nn = n - 512; return 256 * (nn >> 7) + 128 + (nn & 127); }
  if (n < 2048) { const int which = (n - 1024) >> 9, nn = (n - 1024) & 511, head = nn >> 7, d = nn & 127; return 256 * (4 + 2 * which + (head >> 1)) + 128 * (d >> 6) + 64 * (head & 1) + (d & 63); }
  return n;
}
template <int MODE>
DI void transpose_item(const float* W, int K, int N, const float* gk, bf16_t* WT, LAS float* scr, int item, int lane) {
  const int nblk = N / 64, kb = item / nblk, nb = item % nblk, k0 = 64 * kb, n0 = 64 * nb;
  const float* src = W + (size_t)k0 * N + n0 + lane;
  float w[64];
#pragma unroll
  for (int i = 0; i < 64; ++i) w[i] = src[(size_t)i * N];
  if (gk) {
#pragma unroll
    for (int i = 0; i < 64; ++i) w[i] *= gk[k0 + i];
  }
#pragma unroll
  for (int i = 0; i < 64; ++i) scr[i * 65 + lane] = w[i];
  asm volatile("s_waitcnt lgkmcnt(0)" ::: "memory");
  const int c = lane & 7;
#pragma unroll
  for (int j = 0; j < 8; ++j) { const int n = (lane >> 3) + 8 * j; const LAS float* s = scr + (8 * c) * 65 + n;
    u32x4 o; o.x = cvt_pk_bf16(s[0 * 65], s[1 * 65]); o.y = cvt_pk_bf16(s[2 * 65], s[3 * 65]); o.z = cvt_pk_bf16(s[4 * 65], s[5 * 65]); o.w = cvt_pk_bf16(s[6 * 65], s[7 * 65]);
    const int ng = n0 + n;
    const int nm = MODE == 0 ? ng : MODE == 1 ? map_win(ng) : (256 * (ng >> 7) + (MODE == 3 ? 128 : 0) + (ng & 127));
    *(u32x4*)(WT + (size_t)nm * K + k0 + 8 * c) = o; }
  asm volatile("s_waitcnt lgkmcnt(0)" ::: "memory");
}
DI void phase_prologue(const Params& p, LAS unsigned char* lds) {
  int tid = threadIdx.x; asm volatile("" : "+v"(tid));
  const int lane = tid & 63, wave = tid >> 6;
  const int gw = blockIdx.x * 8 + wave, NGW = gridDim.x * 8;
  LAS float* scr = (LAS float*)(lds + wave * 16640);
  unsigned char* ws = p.ws;
  constexpr int I_IN = 16 * 48, I_OUT = 16 * 16, I_G = 16 * 44, I_DN = 44 * 16, I_LAYER = I_IN + I_OUT + 2 * I_G + I_DN;
  for (int it = gw; it < NLAYER * I_LAYER; it += NGW) {
    const int l = it / I_LAYER; int r = it % I_LAYER;
    if (r < I_IN) { transpose_item<1>(p.in[2] + (size_t)l * DM * INW, DM, INW, p.in[1] + l * DM, (bf16_t*)(ws + OFF_WIN + l * SZ_WIN), scr, r, lane); continue; } r -= I_IN;
    if (r < I_OUT) { transpose_item<0>(p.in[8] + (size_t)l * DM * DM, DM, DM, nullptr, (bf16_t*)(ws + OFF_WOUT + l * SZ_WOUT), scr, r, lane); continue; } r -= I_OUT;
    if (r < I_G) { transpose_item<2>(p.in[10] + (size_t)l * DM * DFF, DM, DFF, p.in[9] + l * DM, (bf16_t*)(ws + OFF_WGU + l * SZ_WGU), scr, r, lane); continue; } r -= I_G;
    if (r < I_G) { transpose_item<3>(p.in[11] + (size_t)l * DM * DFF, DM, DFF, p.in[9] + l * DM, (bf16_t*)(ws + OFF_WGU + l * SZ_WGU), scr, r, lane); continue; } r -= I_G;
    transpose_item<0>(p.in[12] + (size_t)l * DFF * DM, DFF, DM, nullptr, (bf16_t*)(ws + OFF_WDN + l * SZ_WDN), scr, r, lane);
  }
  const float* x = p.in[0]; bf16_t* xb = (bf16_t*)(ws + OFF_XB); float* rowsq = (float*)(ws + OFF_ROWSQ);
  for (int row = gw; row < MTOK; row += 2 * NGW) {
    const int row2 = row + NGW;
    const f32x4* xr = (const f32x4*)(x + (size_t)row * DM) + lane; u32x2* o = (u32x2*)(xb + (size_t)row * DM) + lane;
    const bool has2 = row2 < MTOK;
    const f32x4* xr2 = (const f32x4*)(x + (size_t)(has2 ? row2 : row) * DM) + lane; u32x2* o2 = (u32x2*)(xb + (size_t)(has2 ? row2 : row) * DM) + lane;
    f32x4 v[4], v2[4];
#pragma unroll
    for (int j = 0; j < 4; ++j) { v[j] = xr[64 * j]; v2[j] = xr2[64 * j]; }
    float s = 0.f, s2 = 0.f;
#pragma unroll
    for (int j = 0; j < 4; ++j) { s += (v[j][0] * v[j][0] + v[j][1] * v[j][1]) + (v[j][2] * v[j][2] + v[j][3] * v[j][3]); u32x2 w; w.x = cvt_pk_bf16(v[j][0], v[j][1]); w.y = cvt_pk_bf16(v[j][2], v[j][3]); o[64 * j] = w;
      s2 += (v2[j][0] * v2[j][0] + v2[j][1] * v2[j][1]) + (v2[j][2] * v2[j][2] + v2[j][3] * v2[j][3]); u32x2 w2; w2.x = cvt_pk_bf16(v2[j][0], v2[j][1]); w2.y = cvt_pk_bf16(v2[j][2], v2[j][3]); o2[64 * j] = w2; }
    s = wave_sum(s); s2 = wave_sum(s2);
    if (lane == 0) { rowsq[row] = s; if (has2) rowsq[row2] = s2; }
  }
  const int gt = blockIdx.x * 512 + tid, NGT = gridDim.x * 512;
  for (int i = gt; i < 8 * MTOK; i += NGT) rowsq[MTOK + i] = 0.f;
  float* cs = (float*)(ws + OFF_COS); float* sn = (float*)(ws + OFF_SIN);
  for (int i = gt; i < SEQ * 64; i += NGT) {
    const int pos = i >> 6, fi = i & 63;
    const double freq = exp(-(double)fi * (9.210340371976184 / 64.0));
    const double t = (double)pos * freq * 0.6366197723675814;
    const double qd = rint(t); const double r = (t - qd) * 1.5707963267948966; const double r2 = r * r;
    const double sv = r * (1.0 + r2 * (-1.0 / 6 + r2 * (1.0 / 120 + r2 * (-1.0 / 5040 + r2 * (1.0 / 362880 + r2 * (-1.0 / 39916800))))));
    const double cv = 1.0 + r2 * (-0.5 + r2 * (1.0 / 24 + r2 * (-1.0 / 720 + r2 * (1.0 / 40320 + r2 * (-1.0 / 3628800 + r2 * (1.0 / 479001600))))));
    const int qi = ((int)qd) & 3;
    const double s_ = qi == 0 ? sv : qi == 1 ? cv : qi == 2 ? -sv : -cv;
    const double c_ = qi == 0 ? cv : qi == 1 ? -sv : qi == 2 ? -cv : sv;
    cs[i] = (float)c_; sn[i] = (float)s_;
  }
}

DI void conv_load(const bf16_t* U0, int item, int tid, u32x4 (&pf)[8]) {
  const int b = item >> 8, t0 = (item & 255) * 32;
#pragma unroll
  for (int i = 0; i < 8; ++i) { const int id = tid + 512 * i, row = id >> 6, ch = id & 63, tok = t0 - 30 + row; const bool ok = (id < 62 * 64) && (tok >= 0);
    const u32x4 v = *(const u32x4*)(U0 + ((size_t)(b * SEQ + (ok ? tok : 0))) * 512 + ch * 8);
    pf[i] = ok ? v : (u32x4){0u, 0u, 0u, 0u}; }
}
DI void conv_items(const Params& p, int l, int first, int stride, int limit, LAS unsigned char* lds) {
  int tid = threadIdx.x; asm volatile("" : "+v"(tid));
  const int lane = tid & 63, wave = tid >> 6;
  const bf16_t* U0 = (const bf16_t*)(p.ws + OFF_U0); bf16_t* MIX = (bf16_t*)(p.ws + OFF_MIX);
  LAS unsigned char* in = lds;
  LAS float* st = (LAS float*)(lds + 63488);
  if (first >= limit) return;
  u32x4 pf[8];
  conv_load(U0, first, tid, pf);
  const int cs_ = tid >> 8, cp_ = tid & 255;
  f32x2 wv[CONVK];
  { const float* cw = p.in[3] + (size_t)l * CONVK * CWID + 2 * cp_;
#pragma unroll
    for (int j = 0; j < CONVK; ++j) wv[j] = *(const f32x2*)(cw + j * CWID); }
  const f32x2 bb = *(const f32x2*)(p.in[4] + l * CWID + 2 * cp_);
  const f32x4 g0 = *(const f32x4*)(p.in[5] + l * CWID + lane * 8), g1 = *(const f32x4*)(p.in[5] + l * CWID + lane * 8 + 4), b0 = *(const f32x4*)(p.in[6] + l * CWID + lane * 8), b1 = *(const f32x4*)(p.in[6] + l * CWID + lane * 8 + 4);
  for (int item = first; item < limit; item += stride) {
  const int b = item >> 8, t0 = (item & 255) * 32;
#pragma unroll
  for (int i = 0; i < 8; ++i) { const int id = tid + 512 * i; if (id < 62 * 64) *(LAS u32x4*)(in + (id >> 6) * 1024 + (id & 63) * 16) = pf[i]; }
  __syncthreads();
  if (item + stride < limit) conv_load(U0, item + stride, tid, pf);
  {
    const int s = cs_, cp = cp_;
    f32x2 av[16];
#pragma unroll
    for (int o = 0; o < 16; ++o) av[o] = bb;
#pragma unroll
    for (int ii = 0; ii < 46; ++ii) {
      const unsigned xw = *(const LAS unsigned*)(in + (16 * s + ii) * 1024 + cp * 4); const f32x2 xv = (f32x2){bf_lo(xw), bf_hi(xw)};
#pragma unroll
      for (int o = 0; o < 16; ++o) { const int j = ii - o; if (j >= 0 && j < CONVK) av[o] = __builtin_elementwise_fma(wv[j], xv, av[o]); }
    }
#pragma unroll
    for (int o = 0; o < 16; ++o) *(LAS f32x2*)(st + (16 * s + o) * 516 + 2 * cp) = av[o];
  }
  __syncthreads();
  {
#pragma unroll
    for (int tt = 0; tt < 4; ++tt) {
      const int oo = wave * 4 + tt;
      const LAS float* r = st + oo * 516 + lane * 8;
      const f32x4 A = *(const LAS f32x4*)r, B = *(const LAS f32x4*)(r + 4);
      float s1 = (A[0] + A[1]) + (A[2] + A[3]) + (B[0] + B[1]) + (B[2] + B[3]);
      float s2 = (A[0] * A[0] + A[1] * A[1]) + (A[2] * A[2] + A[3] * A[3]) + (B[0] * B[0] + B[1] * B[1]) + (B[2] * B[2] + B[3] * B[3]);
#pragma unroll
      for (int o = 1; o < 64; o <<= 1) { s1 += __shfl_xor(s1, o); s2 += __shfl_xor(s2, o); }
      const float mean = s1 * (1.0f / CWID);
      const float var = fmaxf(s2 * (1.0f / CWID) - mean * mean, 0.f);
      const f32x4 dA = A - mean, dB = B - mean;
      const float rstd = rsqrtf(var + EPS);
      f32x4 y0 = dA * rstd * g0 + b0, y1 = dB * rstd * g1 + b1;
#pragma unroll
      for (int j = 0; j < 4; ++j) { y0[j] = siluf_(y0[j]); y1[j] = siluf_(y1[j]); }
      *(u32x4*)(MIX + ((size_t)(b * SEQ + t0 + oo)) * DM + lane * 8) = pack8(y0, y1);
    }
  }
  __syncthreads();
  }
}

DI bf16x8 tr_pair(const LAS unsigned char* base, int row_stride) {
  const s16x4 lo = __builtin_amdgcn_ds_read_tr16_b64_v4i16((LAS s16x4*)base);
  const s16x4 hi = __builtin_amdgcn_ds_read_tr16_b64_v4i16((LAS s16x4*)(base + 4 * row_stride));
  return __builtin_shufflevector(lo, hi, 0, 1, 2, 3, 4, 5, 6, 7);
}
template <int PASS>
DI void ret_item(const Params& p, int l, int item, LAS unsigned char* lds) {
  constexpr int RS = 272, PS = 144;
  int tid = threadIdx.x; asm volatile("" : "+v"(tid));
  const int lane = tid & 63, wave = __builtin_amdgcn_readfirstlane(tid >> 6), g = lane >> 4, c16 = lane & 15, tq = c16 >> 2, tp = c16 & 3;
  const int b = item >> 6, h = (item >> 4) & 3, seg = item & 15;
  const size_t tokbase = (size_t)b * SEQ + seg * 512;
  const float log2g = __log2f(1.0f - __builtin_amdgcn_exp2f(-5.0f - (float)h));
  const bf16_t* Qg = (const bf16_t*)(p.ws + OFF_Q) + h * 128; const bf16_t* Kg = (const bf16_t*)(p.ws + OFF_K) + h * 128; const bf16_t* Vg = (const bf16_t*)(p.ws + OFF_V) + h * 128;
  const bf16_t* SGg = (const bf16_t*)(p.ws + OFF_SG) + h * 128; bf16_t* MIX = (bf16_t*)(p.ws + OFF_MIX) + 512 + h * 128;
  f32x4* Lb = (f32x4*)(p.ws + OFF_L);
  LAS unsigned char* Qs = lds; LAS unsigned char* Ks = lds + 17408; LAS unsigned char* Vs = lds + 34816; LAS unsigned char* Ps = lds + 52224; LAS unsigned char* Ss = lds + 61440;
  LAS float* stats = (LAS float*)(lds + 96256);
  u32x4 rq[2], rk[2], rv[2];
  f32x4 Sacc[8];
#define RET_LOAD(n) do { _Pragma("unroll") for (int i_ = 0; i_ < 2; ++i_) { const int id_ = tid + 512 * i_, j_ = id_ >> 4, ch_ = id_ & 15; const size_t o_ = (tokbase + (n) * 64 + j_) * 512 + ch_ * 8; \
      rk[i_] = *(const u32x4*)(Kg + o_); rv[i_] = *(const u32x4*)(Vg + o_); if (PASS == 2) rq[i_] = *(const u32x4*)(Qg + o_); } } while (0)
#define RET_STORE() do { _Pragma("unroll") for (int i_ = 0; i_ < 2; ++i_) { const int id_ = tid + 512 * i_, j_ = id_ >> 4, ch_ = id_ & 15; \
      *(LAS u32x4*)(Ks + j_ * RS + ch_ * 16) = rk[i_]; *(LAS u32x4*)(Vs + j_ * RS + ch_ * 16) = rv[i_]; if (PASS == 2) *(LAS u32x4*)(Qs + j_ * RS + ch_ * 16) = rq[i_]; } } while (0)
#define RET_WRITE_S() do { _Pragma("unroll") for (int dt_ = 0; dt_ < 8; ++dt_) { u32x2 w_; w_.x = cvt_pk_bf16(Sacc[dt_][0], Sacc[dt_][1]); w_.y = cvt_pk_bf16(Sacc[dt_][2], Sacc[dt_][3]); \
      *(LAS u32x2*)(Ss + (16 * dt_ + c16) * RS + (16 * wave + 4 * g) * 2) = w_; } } while (0)
  RET_LOAD(0);
  const int it_c = wave & 3, eh_c = wave >> 2, i_c = 16 * it_c + c16;
  u32x2 sg_cur[4], sg_nxt[4]; f32x4 gnv[4];
  if (PASS == 2) {
#pragma unroll
    for (int et = 0; et < 4; ++et) { const int e0 = 64 * eh_c + 16 * et + 4 * g; gnv[et] = *(const f32x4*)(p.in[7] + l * RWID + h * 128 + e0); sg_nxt[et] = *(const u32x2*)(SGg + (tokbase + i_c) * 512 + e0); }
  }
#pragma unroll
  for (int dt = 0; dt < 8; ++dt) Sacc[dt] = (f32x4){0.f, 0.f, 0.f, 0.f};
  if (PASS == 2) {
    const f32x4* Lp = Lb + (size_t)item * 4096 + (wave * 8) * 64 + lane;
#pragma unroll
    for (int dt = 0; dt < 8; ++dt) Sacc[dt] = Lp[dt * 64];
  }
  RET_STORE();
  if (PASS == 2) RET_WRITE_S();
  __syncthreads();
  const float g64 = __builtin_amdgcn_exp2f(log2g * 64.0f);
  float dB[2][4]; float gi_c = 0.f;
  if (PASS == 2) {
    const int jt_ = wave >> 1, it0_ = 2 * (wave & 1);
#pragma unroll
    for (int t = 0; t < 2; ++t)
#pragma unroll
      for (int r = 0; r < 4; ++r) { const int i = 16 * (it0_ + t) + c16, j = 16 * jt_ + 4 * g + r; dB[t][r] = __builtin_amdgcn_exp2f(log2g * (float)((i > j ? i - j : j - i) + j - 63)); }
    gi_c = __builtin_amdgcn_exp2f(log2g * (float)(i_c + 1));
  }
  for (int n = 0; n < 8; ++n) {
    if (n < 7) RET_LOAD(n + 1);
    if (PASS == 2) {
#pragma unroll
      for (int et = 0; et < 4; ++et) { sg_cur[et] = sg_nxt[et]; if (n < 7) sg_nxt[et] = *(const u32x2*)(SGg + (tokbase + (n + 1) * 64 + i_c) * 512 + 64 * eh_c + 16 * et + 4 * g); }
      {
        const int jt = wave >> 1, it0 = 2 * (wave & 1);
        f32x4 sacc[2] = {(f32x4){0.f, 0.f, 0.f, 0.f}, (f32x4){0.f, 0.f, 0.f, 0.f}};
        bf16x8 ka[4], qb[2][4];
#pragma unroll
        for (int ks = 0; ks < 4; ++ks) { ka[ks] = *(const LAS bf16x8*)(Ks + (16 * jt + c16) * RS + (32 * ks + 8 * g) * 2);
#pragma unroll
          for (int t = 0; t < 2; ++t) qb[t][ks] = *(const LAS bf16x8*)(Qs + (16 * (it0 + t) + c16) * RS + (32 * ks + 8 * g) * 2); }
        __builtin_amdgcn_sched_barrier(0);
#pragma unroll
        for (int ks = 0; ks < 4; ++ks)
#pragma unroll
          for (int t = 0; t < 2; ++t) sacc[t] = __builtin_amdgcn_mfma_f32_16x16x32_bf16(ka[ks], qb[t][ks], sacc[t], 0, 0, 0);
        __builtin_amdgcn_sched_barrier(0);
#pragma unroll
        for (int t = 0; t < 2; ++t) { const int i = 16 * (it0 + t) + c16; float pv[4];
#pragma unroll
          for (int r = 0; r < 4; ++r) pv[r] = sacc[t][r] * dB[t][r];
          u32x2 w_; w_.x = cvt_pk_bf16(pv[0], pv[1]); w_.y = cvt_pk_bf16(pv[2], pv[3]);
          *(LAS u32x2*)(Ps + i * PS + (16 * jt + 4 * g) * 2) = w_; }
      }
    }
    f32x4 accI[4], accX[4];
    const int it = wave & 3, eh = wave >> 2, i = 16 * it + c16;
    if (PASS == 2) {
#pragma unroll
      for (int et = 0; et < 4; ++et) { accI[et] = (f32x4){0.f, 0.f, 0.f, 0.f}; accX[et] = (f32x4){0.f, 0.f, 0.f, 0.f}; }
#pragma unroll
      for (int kh = 0; kh < 2; ++kh) {
        bf16x8 bq[2], as_[2][4];
#pragma unroll
        for (int k2 = 0; k2 < 2; ++k2) { const int ks = 2 * kh + k2; bq[k2] = *(const LAS bf16x8*)(Qs + i * RS + (32 * ks + 8 * g) * 2);
#pragma unroll
          for (int et = 0; et < 4; ++et) as_[k2][et] = tr_pair(Ss + (32 * ks + 8 * g + tq) * RS + (64 * eh + 16 * et + 4 * tp) * 2, RS); }
        __builtin_amdgcn_sched_barrier(0);
#pragma unroll
        for (int k2 = 0; k2 < 2; ++k2)
#pragma unroll
          for (int et = 0; et < 4; ++et) accX[et] = __builtin_amdgcn_mfma_f32_16x16x32_bf16(as_[k2][et], bq[k2], accX[et], 0, 0, 0);
        __builtin_amdgcn_sched_barrier(0);
      }
    }
    if (PASS == 1 || n < 7) {
#pragma unroll
      for (int dt = 0; dt < 8; ++dt) Sacc[dt] *= g64;
#pragma unroll
      for (int ks = 0; ks < 2; ++ks) {
        bf16x8 bk[8];
        const bf16x8 a = tr_pair(Vs + (32 * ks + 8 * g + tq) * RS + (16 * wave + 4 * tp) * 2, RS);
#pragma unroll
        for (int dt = 0; dt < 8; ++dt) bk[dt] = tr_pair(Ks + (32 * ks + 8 * g + tq) * RS + (16 * dt + 4 * tp) * 2, RS);
        __builtin_amdgcn_sched_barrier(0);
#pragma unroll
        for (int dt = 0; dt < 8; ++dt) Sacc[dt] = __builtin_amdgcn_mfma_f32_16x16x32_bf16(a, bk[dt], Sacc[dt], 0, 0, 0);
        __builtin_amdgcn_sched_barrier(0);
      }
    }
    __syncthreads();
    if (PASS == 2) {
      {
        bf16x8 bp[2], av[2][4];
#pragma unroll
        for (int ks = 0; ks < 2; ++ks) { bp[ks] = *(const LAS bf16x8*)(Ps + i * PS + (32 * ks + 8 * g) * 2);
#pragma unroll
          for (int et = 0; et < 4; ++et) av[ks][et] = tr_pair(Vs + (32 * ks + 8 * g + tq) * RS + (64 * eh + 16 * et + 4 * tp) * 2, RS); }
        __builtin_amdgcn_sched_barrier(0);
#pragma unroll
        for (int ks = 0; ks < 2; ++ks)
#pragma unroll
          for (int et = 0; et < 4; ++et) accI[et] = __builtin_amdgcn_mfma_f32_16x16x32_bf16(av[ks][et], bp[ks], accI[et], 0, 0, 0);
        __builtin_amdgcn_sched_barrier(0);
      }
      const float gi = gi_c;
      float s1 = 0.f, s2 = 0.f;
#pragma unroll
      for (int et = 0; et < 4; ++et) { accI[et] += accX[et] * gi;
        s1 += (accI[et][0] + accI[et][1]) + (accI[et][2] + accI[et][3]);
        s2 += (accI[et][0] * accI[et][0] + accI[et][1] * accI[et][1]) + (accI[et][2] * accI[et][2] + accI[et][3] * accI[et][3]); }
      s1 += __shfl_xor(s1, 16); s1 += __shfl_xor(s1, 32); s2 += __shfl_xor(s2, 16); s2 += __shfl_xor(s2, 32);
      if (g == 0) { stats[(eh * 64 + i) * 2] = s1; stats[(eh * 64 + i) * 2 + 1] = s2; }
      __syncthreads();
      const float t1 = stats[i * 2] + stats[(64 + i) * 2], t2 = stats[i * 2 + 1] + stats[(64 + i) * 2 + 1];
      const float mean = t1 * (1.0f / 128.0f), var = fmaxf(t2 * (1.0f / 128.0f) - mean * mean, 0.f), rstd = rsqrtf(var + EPS);
      const size_t tok = tokbase + n * 64 + i;
#pragma unroll
      for (int et = 0; et < 4; ++et) { const int e0 = 64 * eh + 16 * et + 4 * g;
        const f32x4 gn = gnv[et]; const u32x2 sgw = sg_cur[et];
        const float v0 = (accI[et][0] - mean) * rstd * gn[0] * bf_lo(sgw.x), v1 = (accI[et][1] - mean) * rstd * gn[1] * bf_hi(sgw.x);
        const float v2 = (accI[et][2] - mean) * rstd * gn[2] * bf_lo(sgw.y), v3 = (accI[et][3] - mean) * rstd * gn[3] * bf_hi(sgw.y);
        u32x2 w_; w_.x = cvt_pk_bf16(v0, v1); w_.y = cvt_pk_bf16(v2, v3);
        *(u32x2*)(MIX + tok * DM + e0) = w_; }
    }
    if (n < 7) { RET_STORE(); if (PASS == 2) RET_WRITE_S(); }
    __syncthreads();
  }
  if (PASS == 1) {
    f32x4* Lp = Lb + (size_t)item * 4096 + (wave * 8) * 64 + lane;
#pragma unroll
    for (int dt = 0; dt < 8; ++dt) Lp[dt * 64] = Sacc[dt];
  }
#undef RET_LOAD
#undef RET_STORE
#undef RET_WRITE_S
}


DI void ret_scan(const Params& p) {
  f32x4* Lb = (f32x4*)(p.ws + OFF_L);
  int tid_ = threadIdx.x; asm volatile("" : "+v"(tid_));
  const int gt = blockIdx.x * 512 + tid_, NGT = gridDim.x * 512;
  for (int idx = gt; idx < 16 * 4096; idx += NGT) {
    const int bh = idx >> 12, e = idx & 4095, h = bh & 3;
    f32x4* base = Lb + (size_t)bh * 16 * 4096 + e;
    const float g512 = __builtin_amdgcn_exp2f(__log2f(1.0f - __builtin_amdgcn_exp2f(-5.0f - (float)h)) * 512.0f);
    f32x4 v[15];
#pragma unroll
    for (int s_ = 0; s_ < 15; ++s_) v[s_] = base[(size_t)s_ * 4096];
    float z_ = 0.f; asm volatile("" : "+v"(z_));
    f32x4 a = (f32x4){z_, z_, z_, z_};
    base[0] = a;
#pragma unroll
    for (int s_ = 0; s_ < 15; ++s_) { a = a * g512 + v[s_]; base[(size_t)(s_ + 1) * 4096] = a; }
  }
}

#define XB_TMO      128
#define XB_XCNT(j)  (256  + 64 * (j))
#define XB_XSUB(j)  (1280 + 64 * (j))
#define XB_XGEN(j)  (2304 + 64 * (j))
#define XB_TOP      3328
#define XB_TOPGEN   3392
#define XCD_BAR_WORDS 3456
#define XB_SPIN_CAP (1u << 18)
DI unsigned xb_ld(unsigned* p)              { return __hip_atomic_load(p, __ATOMIC_RELAXED, __HIP_MEMORY_SCOPE_AGENT); }
DI unsigned xb_add(unsigned* p, unsigned v) { return __hip_atomic_fetch_add(p, v, __ATOMIC_RELAXED, __HIP_MEMORY_SCOPE_AGENT); }
DI unsigned xb_xcc_id() { return (unsigned)__builtin_amdgcn_s_getreg((3 << 11) | 20) & 0xFu; }
#define XB_SPIN(cond, bar) do { unsigned _sp = 0; while (cond) { __builtin_amdgcn_s_sleep(1); \
    if ((++_sp & 255u) == 0u) { if (xb_ld(&(bar)[XB_TMO])) break; if (_sp > XB_SPIN_CAP) { atomicAdd(&(bar)[XB_TMO], 1u); break; } } } } while (0)
struct XcdBarrier { unsigned* bar; unsigned x; volatile LAS unsigned* st; };
DI XcdBarrier xcd_barrier_post(unsigned* bar, volatile LAS unsigned* st) {
  XcdBarrier b; b.bar = bar; b.x = xb_xcc_id(); b.st = st;
  if (threadIdx.x == 0) (void)xb_add(&bar[XB_XCNT(b.x)], 1u);
  return b;
}
DI void xcd_barrier_complete(unsigned* bar, unsigned x, unsigned& nloc, unsigned& nx) {
  const unsigned G = gridDim.x * gridDim.y * gridDim.z;
  unsigned sum, cnt, mine, sp = 0u;
  for (;;) {
    sum = 0u; cnt = 0u; mine = 0u;
#pragma unroll
    for (unsigned j = 0; j < 16; ++j) { const unsigned c = xb_ld(&bar[XB_XCNT(j)]); sum += c; cnt += (c > 0u) ? 1u : 0u; mine = (j == x) ? c : mine; }
    if (sum == G) break;
    __builtin_amdgcn_s_sleep(1);
    if ((++sp & 255u) == 0u) { if (xb_ld(&bar[XB_TMO])) break; if (sp > XB_SPIN_CAP) { atomicAdd(&bar[XB_TMO], 1u); break; } }
  }
  nloc = mine > 0u ? mine : 1u; nx = cnt > 0u ? cnt : 1u;
}
DI void xcd_barrier(const XcdBarrier& b) {
  asm volatile("s_waitcnt vmcnt(0)" ::: "memory");
  __syncthreads();
  if (threadIdx.x == 0) {
    unsigned* bar = b.bar;
    __builtin_amdgcn_s_waitcnt(0);
    unsigned nloc = b.st[0], nx = b.st[1];
    if (nloc == 0u) { xcd_barrier_complete(bar, b.x, nloc, nx); b.st[0] = nloc; b.st[1] = nx; }
    const unsigned old = xb_add(&bar[XB_XSUB(b.x)], 1u);
    const unsigned gen = old / nloc;
    if (old + 1u == (gen + 1u) * nloc) {
      __builtin_amdgcn_fence(__ATOMIC_RELEASE, "agent");
      asm volatile("s_waitcnt vmcnt(0)" ::: "memory");
      const unsigned og = xb_add(&bar[XB_TOP], 1u);
      const unsigned tg = og / nx;
      if (og + 1u == (tg + 1u) * nx) xb_add(&bar[XB_TOPGEN], 1u);
      else XB_SPIN(xb_ld(&bar[XB_TOPGEN]) == tg, bar);
      __builtin_amdgcn_fence(__ATOMIC_ACQUIRE, "agent");
      xb_add(&bar[XB_XGEN(b.x)], 1u);
      asm volatile("s_waitcnt vmcnt(0)" ::: "memory");
    } else {
      XB_SPIN(xb_ld(&bar[XB_XGEN(b.x)]) == gen, bar);
      __builtin_amdgcn_fence(__ATOMIC_ACQUIRE, "agent");
      asm volatile("s_waitcnt vmcnt(0)" ::: "memory");
    }
  }
  __syncthreads();
}

extern __shared__ __attribute__((aligned(16))) unsigned char smem_dyn[];

__global__ void __launch_bounds__(512) fwd_mega(Params p) {
  cg::grid_group grid = cg::this_grid();
  LAS unsigned char* lds = (LAS unsigned char*)smem_dyn;
  unsigned char* ws = p.ws;
  float* rowsq = (float*)(ws + OFF_ROWSQ);
  bf16_t* XB = (bf16_t*)(ws + OFF_XB); unsigned char* XLO = ws + OFF_XLO;
  const int G = gridDim.x, c = blockIdx.x;
  volatile LAS unsigned* bst = (volatile LAS unsigned*)(lds + 133120);
  if (threadIdx.x == 0) { bst[0] = 0u; bst[1] = 0u; }
  __syncthreads();
  const XcdBarrier xbar = xcd_barrier_post((unsigned*)(ws + OFF_BAR), bst);
#define GSYNC() xcd_barrier(xbar)

  phase_prologue(p, lds);
  grid.sync();

  for (int l = 0; l < NLAYER; ++l) {
    { pg8::Gemm gm{XB, (const bf16_t*)(ws + OFF_WIN + l * SZ_WIN), MTOK, INW, DM};
      pg8::StaticOrder so; so.init(MTOK, INW, G, c);
      EpiIn e{rowsq + (size_t)(2 * l) * MTOK, (bf16_t*)(ws + OFF_U0), (bf16_t*)(ws + OFF_Q), (bf16_t*)(ws + OFF_K), (bf16_t*)(ws + OFF_V), (bf16_t*)(ws + OFF_SG), (const float*)(ws + OFF_COS), (const float*)(ws + OFF_SIN)};
      pg8::gemm_phase(lds, gm, so, e); }
    GSYNC();
    for (int it = c; it < 256; it += G) ret_item<1>(p, l, it, lds);
    if (G == 256) { const int x_ = c & 7, j_ = c >> 3; conv_items(p, l, 128 * x_ + j_, 32, 128 * x_ + 128, lds); }
    else conv_items(p, l, c, G, 1024, lds);
    GSYNC();
    ret_scan(p);
    GSYNC();
    for (int it = c; it < 256; it += G) ret_item<2>(p, l, it, lds);
    GSYNC();
    { pg8::Gemm gm{(const bf16_t*)(ws + OFF_MIX), (const bf16_t*)(ws + OFF_WOUT + l * SZ_WOUT), MTOK, DM, DM};
      pg8::StaticOrder so; so.init(MTOK, DM, G, c);
      EpiRes e{p.in[0], p.out, XB, XLO, rowsq + (size_t)(2 * l + 1) * MTOK, l == 0, 0, p.in[13], (unsigned*)(ws + OFF_BAR) + 3584};
      pg8::gemm_phase(lds, gm, so, e);
 }
    GSYNC();
    { pg8::Gemm gm{XB, (const bf16_t*)(ws + OFF_WGU + l * SZ_WGU), MTOK, 2 * DFF, DM};
      pg8::StaticOrder so; so.init(MTOK, 2 * DFF, G, c);
      EpiGU e{rowsq + (size_t)(2 * l + 1) * MTOK, (bf16_t*)(ws + OFF_HID)};
      pg8::gemm_phase(lds, gm, so, e);
 }
    GSYNC();
    { pg8::Gemm gm{(const bf16_t*)(ws + OFF_HID), (const bf16_t*)(ws + OFF_WDN + l * SZ_WDN), MTOK, DM, DFF};
      pg8::StaticOrder so; so.init(MTOK, DM, G, c);
      EpiRes e{p.in[0], p.out, XB, XLO, rowsq + (size_t)(2 * l + 2) * MTOK, 0, l == NLAYER - 1, p.in[13], (unsigned*)(ws + OFF_BAR) + 3584};
      pg8::gemm_phase(lds, gm, so, e);
 }
    if (l < NLAYER - 1) GSYNC();
  }
}

extern "C" void kernel_launch(void* const* d_in, const int* in_sizes, int n_in, void* d_out, int out_size, void* d_ws, size_t ws_size, hipStream_t stream) {
  static int grid_blocks = 0;
  if (!grid_blocks) {
    int dev = 0, cus = 0, per_cu = 0;
    (void)hipGetDevice(&dev);
    (void)hipDeviceGetAttribute(&cus, hipDeviceAttributeMultiprocessorCount, dev);
    (void)hipFuncSetAttribute((const void*)fwd_mega, hipFuncAttributeMaxDynamicSharedMemorySize, LDS_BYTES);
    (void)hipOccupancyMaxActiveBlocksPerMultiprocessor(&per_cu, (const void*)fwd_mega, 512, LDS_BYTES);
    if (n_in != 14 || out_size != MTOK * DM || ws_size < WS_END) { fprintf(stderr, "kernel_launch: unexpected shapes (n_in %d out %d ws %zu need %zu)\n", n_in, out_size, ws_size, (size_t)WS_END); grid_blocks = -1; return; }
    grid_blocks = cus;
    fprintf(stderr, "kernel_launch: cus %d per_cu %d grid %d\n", cus, per_cu, grid_blocks);
  }
  if (grid_blocks < 0) return;
  (void)hipMemsetAsync((unsigned char*)d_ws + OFF_BAR, 0, 16384, stream);
  Params p{};
  for (int i = 0; i < 14; ++i) p.in[i] = (const float*)d_in[i];
  p.out = (float*)d_out; p.ws = (unsigned char*)d_ws;
  void* args[] = {&p};
  hipError_t e = hipLaunchCooperativeKernel((void*)fwd_mega, dim3(grid_blocks), dim3(512), args, LDS_BYTES, stream);
  if (e != hipSuccess) fprintf(stderr, "cooperative launch failed: %s (grid %d)\n", hipGetErrorString(e), grid_blocks);
}
```

```cpp
#include <hip/hip_runtime.h>
#include <hip/hip_cooperative_groups.h>
#include <cstdio>
namespace cg = cooperative_groups;

#define LAS __attribute__((address_space(3)))
#define DI __device__ __forceinline__
typedef unsigned short bf16_t;
typedef short bf16x8 __attribute__((ext_vector_type(8)));
typedef short s16x4 __attribute__((ext_vector_type(4)));
typedef float f32x4 __attribute__((ext_vector_type(4)));
typedef float f32x2 __attribute__((ext_vector_type(2)));
typedef unsigned u32x4 __attribute__((ext_vector_type(4)));
typedef unsigned u32x2 __attribute__((ext_vector_type(2)));

constexpr int MTOK = 32768, DM = 1024, SEQ = 8192, CWID = 512, RWID = 512, INW = 3072, DFF = 2816, NLAYER = 4, CONVK = 31;
constexpr float EPS = 1e-6f;
constexpr size_t SZ_WIN = (size_t)INW * DM * 2, SZ_WOUT = (size_t)DM * DM * 2, SZ_WGU = (size_t)2 * DFF * DM * 2, SZ_WDN = (size_t)DM * DFF * 2;
constexpr size_t OFF_WIN = 0, OFF_WOUT = OFF_WIN + NLAYER * SZ_WIN, OFF_WGU = OFF_WOUT + NLAYER * SZ_WOUT, OFF_WDN = OFF_WGU + NLAYER * SZ_WGU;
constexpr size_t OFF_XB = OFF_WDN + NLAYER * SZ_WDN;
constexpr size_t SZ_HALF = (size_t)MTOK * 512 * 2;
constexpr size_t OFF_ACT = OFF_XB + (size_t)MTOK * DM * 2;
constexpr size_t OFF_U0 = OFF_ACT, OFF_Q = OFF_U0 + SZ_HALF, OFF_K = OFF_Q + SZ_HALF, OFF_V = OFF_K + SZ_HALF, OFF_SG = OFF_V + SZ_HALF, OFF_MIX = OFF_SG + SZ_HALF;
constexpr size_t OFF_HID = OFF_ACT;
constexpr size_t OFF_ROWSQ = OFF_MIX + (size_t)MTOK * DM * 2;
constexpr size_t OFF_COS = OFF_ROWSQ + (size_t)9 * MTOK * 4, OFF_SIN = OFF_COS + (size_t)SEQ * 64 * 4;
constexpr size_t OFF_L = OFF_SIN + (size_t)SEQ * 64 * 4;
constexpr size_t OFF_BAR = OFF_L + (size_t)256 * 65536;
constexpr size_t OFF_XLO = OFF_BAR + 16384;
constexpr size_t WS_END = OFF_XLO + (size_t)MTOK * DM;
static_assert((size_t)MTOK * DFF * 2 <= OFF_ROWSQ - OFF_ACT, "HID alias too big");
constexpr int LDS_BYTES = 133120 + 256;

struct Params { const float* in[14]; float* out; unsigned char* ws; };

DI unsigned cvt_pk_bf16(float lo, float hi) { unsigned r; asm volatile("v_cvt_pk_bf16_f32 %0, %1, %2" : "=v"(r) : "v"(lo), "v"(hi)); return r; }
DI float bf_lo(unsigned w) { return __uint_as_float(w << 16); }
DI float bf_hi(unsigned w) { return __uint_as_float(w & 0xffff0000u); }
DI float fast_rcp(float x) { return __builtin_amdgcn_rcpf(x); }
DI float fexp(float x) { return __builtin_amdgcn_exp2f(x * 1.44269504089f); }
DI float sigmoidf_(float x) { return fast_rcp(1.0f + fexp(-x)); }
DI float siluf_(float x) { return x * sigmoidf_(x); }
DI float wave_sum(float v) {
#pragma unroll
  for (int o = 1; o < 64; o <<= 1) v += __shfl_xor(v, o);
  return v;
}

namespace pg8 {
constexpr int BM = 256, BK = 64, HALF = 128, HTB = HALF * BK * 2, STAGE_BYTES = 8 * HTB, NXCD = 8, WGM = 8;
DI int lds_byte(int r, int c) { const int st = (r >> 4) * 2 + (c >> 5), rr = r & 15, cc = c & 31, ob = rr * 64 + cc * 2; return st * 1024 + (ob ^ (((ob >> 9) & 1) << 5)); }
DI void stage_rc(int b, int& R, int& C) { const int st = b / 1024, sb = b % 1024, swz = sb ^ (((sb >> 9) & 1) << 5); R = (st >> 1) * 16 + swz / 64; C = (st & 1) * 32 + (swz % 64) / 2; }
DI int perm32(int rho) { const int n = rho >> 4, i = rho & 15; return 8 * (i >> 2) + 4 * n + (i & 3); }
struct Unit { int pm, pn; };
struct Gemm { const bf16_t* A; const bf16_t* Bt; int M, N, K; };
struct StaticOrder {
  int nM, nN, nwg, G, c;
  DI void init(int M, int N, int G_, int c_) { nM = M / BM; nN = N / BM; nwg = nM * nN; G = G_; c = c_; }
  DI bool next(int i, Unit& u) const {
    const long L = (long)i * G + c; if (L >= nwg) return false;
    int wgid = (int)L; { const int q = nwg / NXCD, r = nwg % NXCD, xcd = wgid % NXCD, off = wgid / NXCD; wgid = (xcd < r ? xcd * (q + 1) : r * (q + 1) + (xcd - r) * q) + off; }
    const int nig = WGM * nN, gid = wgid / nig, fm = gid * WGM, gsz = (nM - fm) < WGM ? (nM - fm) : WGM;
    u.pm = fm + ((wgid % nig) % gsz); u.pn = (wgid % nig) / gsz; return true;
  }
};

template <class Epi>
DI void gemm_phase(LAS unsigned char* lds, const Gemm g, const StaticOrder& S, const Epi& E) {
  int tid = threadIdx.x; asm volatile("" : "+v"(tid));
  const int wid = __builtin_amdgcn_readfirstlane(tid >> 6), lane = tid & 63, wr = wid >> 2, wc = wid & 3, fr = lane & 15, fq = lane >> 4;
  const int K = g.K, nt = K / BK;
  unsigned voffA[2], voffB[2];
#pragma unroll
  for (int i = 0; i < 2; ++i) { int R, C; stage_rc(tid * 16 + i * 8192, R, C); const int Rb = (R & ~31) + perm32(R & 31);
    voffA[i] = (unsigned)(R * K + C) * 2u; voffB[i] = (unsigned)(Rb * K + C) * 2u; }
  const size_t kstep = (size_t)(BK * 2);
  const size_t hstep = (size_t)HALF * K * 2;
  const size_t tstep = 2 * hstep;
  const unsigned ldsw = (unsigned)wid * 1024u;
  const int aoff = lds_byte(wr * 64 + fr, fq * 8), boff = lds_byte(wc * 32 + fr, fq * 8);
#define PG8_SA(b, h) (((b) * 2 + (h)) * HTB)
#define PG8_SB(b, h) ((4 + (b) * 2 + (h)) * HTB)
#define PG8_STAGE(bufoff, gbase, voff) do { _Pragma("unroll") for (int _i = 0; _i < 2; ++_i) \
        __builtin_amdgcn_global_load_lds((const unsigned*)((const char*)(gbase) + (voff)[_i]), (LAS unsigned*)(lds + (bufoff) + ldsw + _i * 8192), 16, 0, 0); } while (0)
#define PG8_LDA(dst, b, h) do { _Pragma("unroll") for (int m = 0; m < 4; ++m) _Pragma("unroll") for (int k = 0; k < 2; ++k) dst[m][k] = *(const LAS bf16x8*)(lds + PG8_SA(b, h) + aoff + m * 2048 + k * 1024); } while (0)
#define PG8_LDB(dst, b, h) do { _Pragma("unroll") for (int n = 0; n < 2; ++n) _Pragma("unroll") for (int k = 0; k < 2; ++k) dst[n][k] = *(const LAS bf16x8*)(lds + PG8_SB(b, h) + boff + n * 2048 + k * 1024); } while (0)
#define PG8_MMA(ai, bj, At, Bt) do { __builtin_amdgcn_s_setprio(1); _Pragma("unroll") for (int m = 0; m < 4; ++m) _Pragma("unroll") for (int n = 0; n < 2; ++n) _Pragma("unroll") for (int k = 0; k < 2; ++k) \
        acc[ai][bj][m][n] = __builtin_amdgcn_mfma_f32_16x16x32_bf16(Bt[n][k], At[m][k], acc[ai][bj][m][n], 0, 0, 0); __builtin_amdgcn_s_setprio(0); } while (0)
#define PG8_WAIT_V(n) asm volatile("s_waitcnt vmcnt(" #n ")" ::: "memory")
#define PG8_WAIT_L(n) asm volatile("s_waitcnt lgkmcnt(" #n ")" ::: "memory")
#define PG8_BAR __builtin_amdgcn_s_barrier()
#define PG8_SCHED __builtin_amdgcn_sched_barrier(0)
  Unit cur, nxt; int ui = 0;
  if (!S.next(0, cur)) return;
  f32x4 acc[2][2][4][2];
  float zf = 0.f; asm volatile("" : "+v"(zf));
#pragma unroll
  for (int a = 0; a < 2; ++a)
#pragma unroll
    for (int b = 0; b < 2; ++b)
#pragma unroll
      for (int m = 0; m < 4; ++m)
#pragma unroll
        for (int n = 0; n < 2; ++n) acc[a][b][m][n] = (f32x4){zf, zf, zf, zf};
  bf16x8 At[4][2], B0[2][2], B1[2][2];
  const char* cA = (const char*)g.A + (size_t)cur.pm * tstep; const char* cB = (const char*)g.Bt + (size_t)cur.pn * tstep;
  PG8_STAGE(PG8_SB(0, 0), cB, voffB); PG8_STAGE(PG8_SB(0, 1), cB + hstep, voffB); PG8_STAGE(PG8_SA(0, 0), cA, voffA); PG8_STAGE(PG8_SA(0, 1), cA + hstep, voffA);
  if (wr == 1) PG8_BAR;
  PG8_WAIT_V(2); PG8_BAR;
  PG8_STAGE(PG8_SB(1, 0), cB + kstep, voffB); PG8_STAGE(PG8_SA(1, 0), cA + kstep, voffA); PG8_STAGE(PG8_SB(1, 1), cB + hstep + kstep, voffB);
  PG8_WAIT_V(6); PG8_BAR;
  for (;;) {
    const bool has_next = S.next(ui + 1, nxt);
    const char* nA = has_next ? (const char*)g.A + (size_t)nxt.pm * tstep : cA; const char* nB = has_next ? (const char*)g.Bt + (size_t)nxt.pn * tstep : cB;
    for (int t = 0; t < nt; t += 2) {
      const bool last = (t == nt - 2);
      const char* a1 = cA + (size_t)(t + 1) * kstep;
      const char* a2 = last ? nA : cA + (size_t)(t + 2) * kstep; const char* b2 = last ? nB : cB + (size_t)(t + 2) * kstep;
      const char* a3 = a2 + kstep; const char* b3 = b2 + kstep;
      PG8_LDB(B0, 0, 0); PG8_LDB(B1, 0, 1); PG8_SCHED; PG8_LDA(At, 0, 0); PG8_STAGE(PG8_SA(1, 1), a1 + hstep, voffA);
      PG8_WAIT_V(8); PG8_WAIT_L(0); PG8_BAR; PG8_MMA(0, 0, At, B0); PG8_MMA(0, 1, At, B1); PG8_BAR; PG8_SCHED;
      PG8_LDA(At, 0, 1); PG8_STAGE(PG8_SB(0, 0), b2, voffB); PG8_STAGE(PG8_SB(0, 1), b2 + hstep, voffB); PG8_STAGE(PG8_SA(0, 0), a2, voffA);
      PG8_WAIT_V(8); PG8_WAIT_L(0); PG8_BAR; PG8_MMA(1, 0, At, B0); PG8_MMA(1, 1, At, B1); PG8_BAR; PG8_SCHED;
      PG8_LDB(B0, 1, 0); PG8_LDB(B1, 1, 1); PG8_SCHED; PG8_LDA(At, 1, 0); PG8_STAGE(PG8_SA(0, 1), a2 + hstep, voffA);
      PG8_WAIT_V(8); PG8_WAIT_L(0); PG8_BAR; PG8_MMA(0, 0, At, B0); PG8_MMA(0, 1, At, B1); PG8_BAR; PG8_SCHED;
      PG8_LDA(At, 1, 1); PG8_STAGE(PG8_SB(1, 0), b3, voffB); PG8_STAGE(PG8_SB(1, 1), b3 + hstep, voffB); PG8_STAGE(PG8_SA(1, 0), a3, voffA);
      PG8_WAIT_V(8); PG8_WAIT_L(0); PG8_BAR; PG8_MMA(1, 0, At, B0); PG8_MMA(1, 1, At, B1); PG8_BAR; PG8_SCHED;
    }
    if (wr == 0) PG8_BAR;
    E(acc, cur, wr, wc, fr, fq);
    if (!has_next) break;
#pragma unroll
    for (int a = 0; a < 2; ++a)
#pragma unroll
      for (int b = 0; b < 2; ++b)
#pragma unroll
        for (int m = 0; m < 4; ++m)
#pragma unroll
          for (int n = 0; n < 2; ++n) acc[a][b][m][n] = (f32x4){zf, zf, zf, zf};
    cur = nxt; cA = nA; cB = nB; ++ui;
    if (wr == 1) PG8_BAR;
  }
  PG8_WAIT_V(0);
  PG8_BAR;
#undef PG8_SA
#undef PG8_SB
#undef PG8_STAGE
#undef PG8_LDA
#undef PG8_LDB
#undef PG8_MMA
#undef PG8_WAIT_V
#undef PG8_WAIT_L
#undef PG8_BAR
#undef PG8_SCHED
}
}

typedef f32x4 AccT[2][2][4][2];
DI u32x4 pack8(const f32x4 a, const f32x4 b) { u32x4 w; w.x = cvt_pk_bf16(a[0], a[1]); w.y = cvt_pk_bf16(a[2], a[3]); w.z = cvt_pk_bf16(b[0], b[1]); w.w = cvt_pk_bf16(b[2], b[3]); return w; }


DI f32x4 sig_scaled(const f32x4 t, float c1) {
  const f32x4 z = t * c1; f32x4 e;
#pragma unroll
  for (int j = 0; j < 4; ++j) e[j] = __builtin_amdgcn_exp2f(z[j]);
  const f32x4 d = e + 1.0f; f32x4 q;
#pragma unroll
  for (int j = 0; j < 4; ++j) q[j] = __builtin_amdgcn_rcpf(d[j]);
  return q;
}
struct EpiIn {
  const float* rowsq; bf16_t *u0, *q, *k, *v, *sg; const float *cs, *sn;
  DI void operator()(const AccT& acc, const pg8::Unit& u, int wr, int wc, int fr, int fq) const {
    const int row0 = u.pm * 256 + wr * 64 + fr, c8 = wc * 32 + 8 * fq, pn = u.pn;
    float rs[2][4];
#pragma unroll
    for (int ai = 0; ai < 2; ++ai)
#pragma unroll
      for (int m = 0; m < 4; ++m) rs[ai][m] = rowsq[row0 + ai * 128 + m * 16];
    __builtin_amdgcn_sched_barrier(0);
    if (pn >= 4 && pn < 8) {
      const int which = (pn - 4) >> 1, head = 2 * ((pn - 4) & 1) + (c8 >> 6), dd = c8 & 63;
      const float lg = which ? __log2f(1.0f - __builtin_amdgcn_exp2f(-5.0f - (float)head)) : 0.f;
#pragma unroll
      for (int ai = 0; ai < 2; ++ai)
#pragma unroll
      for (int mp = 0; mp < 2; ++mp) {
        f32x4 tc[2][2], ts[2][2];
#pragma unroll
        for (int m2 = 0; m2 < 2; ++m2) { const int pos = (row0 + ai * 128 + (2 * mp + m2) * 16) & (SEQ - 1);
          tc[m2][0] = *(const f32x4*)(cs + pos * 64 + dd); tc[m2][1] = *(const f32x4*)(cs + pos * 64 + dd + 4); ts[m2][0] = *(const f32x4*)(sn + pos * 64 + dd); ts[m2][1] = *(const f32x4*)(sn + pos * 64 + dd + 4); }
        __builtin_amdgcn_sched_barrier(0);
#pragma unroll
        for (int m2 = 0; m2 < 2; ++m2) {
          const int m = 2 * mp + m2;
          const int r = row0 + ai * 128 + m * 16;
          const float rstd = rsqrtf(rs[ai][m] * (1.0f / DM) + EPS);
          float sc = rstd;
          if (which) sc *= 0.08838834764831845f * __builtin_amdgcn_exp2f(lg * (float)(63 - (r & 63)));
          const f32x4 a0 = acc[ai][0][m][0] * sc, a1 = acc[ai][0][m][1] * sc, b0 = acc[ai][1][m][0] * sc, b1 = acc[ai][1][m][1] * sc;
          const f32x4 o1a = a0 * tc[m2][0] - b0 * ts[m2][0], o1b = a1 * tc[m2][1] - b1 * ts[m2][1], o2a = a0 * ts[m2][0] + b0 * tc[m2][0], o2b = a1 * ts[m2][1] + b1 * tc[m2][1];
          bf16_t* dst = (which ? k : q) + (size_t)r * 512 + head * 128 + dd;
          *(u32x4*)dst = pack8(o1a, o1b); *(u32x4*)(dst + 64) = pack8(o2a, o2b);
        }
        __builtin_amdgcn_sched_barrier(0);
      }
      return;
    }
#pragma unroll
    for (int ai = 0; ai < 2; ++ai)
#pragma unroll
      for (int m = 0; m < 4; ++m) {
        const int r = row0 + ai * 128 + m * 16;
        const float rstd = rsqrtf(rs[ai][m] * (1.0f / DM) + EPS);
        const float c1 = rstd * -1.44269504089f;
        const f32x4 p0 = acc[ai][0][m][0], p1 = acc[ai][0][m][1], q0 = acc[ai][1][m][0], q1 = acc[ai][1][m][1];
        if (pn < 4) {
          const f32x4 o0 = p0 * (sig_scaled(q0, c1) * rstd), o1 = p1 * (sig_scaled(q1, c1) * rstd);
          *(u32x4*)(u0 + (size_t)r * 512 + pn * 128 + c8) = pack8(o0, o1);
        } else if (pn < 10) {
          bf16_t* dst = v + (size_t)r * 512 + (pn - 8) * 256 + c8;
          *(u32x4*)dst = pack8(p0 * rstd, p1 * rstd); *(u32x4*)(dst + 128) = pack8(q0 * rstd, q1 * rstd);
        } else {
          const f32x4 o0 = p0 * (sig_scaled(p0, c1) * rstd), o1 = p1 * (sig_scaled(p1, c1) * rstd), o2 = q0 * (sig_scaled(q0, c1) * rstd), o3 = q1 * (sig_scaled(q1, c1) * rstd);
          bf16_t* dst = sg + (size_t)r * 512 + (pn - 10) * 256 + c8;
          *(u32x4*)dst = pack8(o0, o1); *(u32x4*)(dst + 128) = pack8(o2, o3);
        }
      }
  }
};
DI void lo_decode8(const u32x4 h, const u32x2 q, f32x4& b0, f32x4& b1) {
  const unsigned hw[4] = {h.x, h.y, h.z, h.w}; float o[8];
#pragma unroll
  for (int t = 0; t < 4; ++t) {
    const unsigned qq = t < 2 ? q.x : q.y; const int sh = (t & 1) * 16;
    const int ql = (int)(qq << (24 - sh)) >> 24, qh = (int)(qq << (16 - sh)) >> 24;
    o[2 * t] = __uint_as_float((hw[t] << 16) + (unsigned)(ql << 8)); o[2 * t + 1] = __uint_as_float((hw[t] & 0xffff0000u) + (unsigned)(qh << 8));
  }
  b0 = (f32x4){o[0], o[1], o[2], o[3]}; b1 = (f32x4){o[4], o[5], o[6], o[7]};
}
DI void lo_encode8(const f32x4 x0, const f32x4 x1, u32x4& h, u32x2& q) {
  h = pack8(x0, x1);
  const unsigned hw[4] = {h.x, h.y, h.z, h.w}; const float xs[8] = {x0[0], x0[1], x0[2], x0[3], x1[0], x1[1], x1[2], x1[3]}; unsigned qb[2] = {0u, 0u};
#pragma unroll
  for (int t = 0; t < 4; ++t) {
    int ql = ((int)(__float_as_uint(xs[2 * t]) - (hw[t] << 16)) + 128) >> 8, qh = ((int)(__float_as_uint(xs[2 * t + 1]) - (hw[t] & 0xffff0000u)) + 128) >> 8;
    ql = ql > 127 ? 127 : ql; qh = qh > 127 ? 127 : qh;
    qb[t >> 1] |= (((unsigned)ql & 0xffu) | (((unsigned)qh & 0xffu) << 8)) << ((t & 1) * 16);
  }
  q.x = qb[0]; q.y = qb[1];
}
DI float sumsq8(const f32x4 x0, const f32x4 x1) { return (x0[0] * x0[0] + x0[1] * x0[1]) + (x0[2] * x0[2] + x0[3] * x0[3]) + (x1[0] * x1[0] + x1[1] * x1[1]) + (x1[2] * x1[2] + x1[3] * x1[3]); }
struct EpiRes {
  const float* base; float* out; bf16_t* hi; unsigned char* lo; float* rowsq_next; int in_f32, out_f32; const float* fg; unsigned* cnt;
  DI void operator()(const AccT& acc, const pg8::Unit& u, int wr, int wc, int fr, int fq) const {
    const int row0 = u.pm * 256 + wr * 64 + fr, col0 = u.pn * 256 + wc * 32 + 8 * fq;
    if (out_f32) {
      AccT& xa = const_cast<AccT&>(acc);
      { u32x4 lh[2][2]; u32x2 lq[2][2];
#define FIN_LOAD(st) do { _Pragma("unroll") for (int bj = 0; bj < 2; ++bj) { const unsigned off = (unsigned)((row0 + ((st) >> 2) * 128 + ((st) & 3) * 16) * DM + col0 + bj * 128); \
        lh[(st) & 1][bj] = *(const u32x4*)(hi + off); lq[(st) & 1][bj] = *(const u32x2*)(lo + off); } } while (0)
        FIN_LOAD(0);
#pragma unroll
        for (int st = 0; st < 8; ++st) {
          if (st < 7) FIN_LOAD(st + 1);
          __builtin_amdgcn_sched_barrier(0);
          const int ai = st >> 2, m = st & 3; const int r = row0 + ai * 128 + m * 16; float ss = 0.f;
#pragma unroll
          for (int bj = 0; bj < 2; ++bj) { f32x4 b0, b1; lo_decode8(lh[st & 1][bj], lq[st & 1][bj], b0, b1);
            xa[ai][bj][m][0] += b0; xa[ai][bj][m][1] += b1; ss += sumsq8(xa[ai][bj][m][0], xa[ai][bj][m][1]); }
          ss += __shfl_xor(ss, 16); ss += __shfl_xor(ss, 32);
          if (fq == 0) atomicAdd(rowsq_next + r, ss);
          __builtin_amdgcn_sched_barrier(0);
        }
#undef FIN_LOAD
      }
      asm volatile("s_waitcnt vmcnt(0)" ::: "memory");
      unsigned* pc = cnt + u.pm * 2 + wr;
      if (fr == 0 && fq == 0) __hip_atomic_fetch_add(pc, 1u, __ATOMIC_RELAXED, __HIP_MEMORY_SCOPE_AGENT);
      { unsigned sp = 0;
        while ((unsigned)__builtin_amdgcn_readfirstlane(__hip_atomic_load(pc, __ATOMIC_RELAXED, __HIP_MEMORY_SCOPE_AGENT)) < 16u) { __builtin_amdgcn_s_sleep(2); if (++sp > (1u << 22)) break; } }
      __builtin_amdgcn_fence(__ATOMIC_ACQUIRE, "agent");
      float rsv[2][4];
#pragma unroll
      for (int ai = 0; ai < 2; ++ai)
#pragma unroll
        for (int m = 0; m < 4; ++m) rsv[ai][m] = rsqrtf(__hip_atomic_load(rowsq_next + row0 + ai * 128 + m * 16, __ATOMIC_RELAXED, __HIP_MEMORY_SCOPE_AGENT) * (1.0f / DM) + EPS);
#pragma unroll
      for (int bj = 0; bj < 2; ++bj) {
        const f32x4 ga = *(const f32x4*)(fg + col0 + bj * 128), gb = *(const f32x4*)(fg + col0 + bj * 128 + 4);
        __builtin_amdgcn_sched_barrier(0);
#pragma unroll
        for (int ai = 0; ai < 2; ++ai)
#pragma unroll
          for (int m = 0; m < 4; ++m) { const unsigned off = (unsigned)((row0 + ai * 128 + m * 16) * DM + col0 + bj * 128);
            *(f32x4*)(out + off) = xa[ai][bj][m][0] * rsv[ai][m] * ga; *(f32x4*)(out + off + 4) = xa[ai][bj][m][1] * rsv[ai][m] * gb; }
        __builtin_amdgcn_sched_barrier(0);
      }
      return;
    }
    if (in_f32) {
      f32x4 lf[2][2][2];
#define INF_LOAD(st) do { _Pragma("unroll") for (int bj = 0; bj < 2; ++bj) { const unsigned off = (unsigned)((row0 + ((st) >> 2) * 128 + ((st) & 3) * 16) * DM + col0 + bj * 128); \
      lf[(st) & 1][bj][0] = *(const f32x4*)(base + off); lf[(st) & 1][bj][1] = *(const f32x4*)(base + off + 4); } } while (0)
      INF_LOAD(0);
#pragma unroll
      for (int st = 0; st < 8; ++st) {
        if (st < 7) INF_LOAD(st + 1);
        __builtin_amdgcn_sched_barrier(0);
        const int ai = st >> 2, m = st & 3; const int r = row0 + ai * 128 + m * 16; float ss = 0.f;
#pragma unroll
        for (int bj = 0; bj < 2; ++bj) { const unsigned off = (unsigned)(r * DM + col0 + bj * 128);
          const f32x4 x0 = lf[st & 1][bj][0] + acc[ai][bj][m][0], x1 = lf[st & 1][bj][1] + acc[ai][bj][m][1];
          u32x4 hw; u32x2 qw; lo_encode8(x0, x1, hw, qw); *(u32x4*)(hi + off) = hw; *(u32x2*)(lo + off) = qw; ss += sumsq8(x0, x1); }
        ss += __shfl_xor(ss, 16); ss += __shfl_xor(ss, 32);
        if (fq == 0) atomicAdd(rowsq_next + r, ss);
        __builtin_amdgcn_sched_barrier(0);
      }
#undef INF_LOAD
      return;
    }
    u32x4 lh[2][2]; u32x2 lq[2][2];
#define RES_LOAD(st) do { _Pragma("unroll") for (int bj = 0; bj < 2; ++bj) { const unsigned off = (unsigned)((row0 + ((st) >> 2) * 128 + ((st) & 3) * 16) * DM + col0 + bj * 128); \
      lh[(st) & 1][bj] = *(const u32x4*)(hi + off); lq[(st) & 1][bj] = *(const u32x2*)(lo + off); } } while (0)
#define RES_COMP(st) do { const int ai = (st) >> 2, m = (st) & 3; const int r = row0 + ai * 128 + m * 16; float ss = 0.f; _Pragma("unroll") for (int bj = 0; bj < 2; ++bj) { const unsigned off = (unsigned)(r * DM + col0 + bj * 128); \
      f32x4 b0, b1; lo_decode8(lh[(st) & 1][bj], lq[(st) & 1][bj], b0, b1); const f32x4 x0 = b0 + acc[ai][bj][m][0], x1 = b1 + acc[ai][bj][m][1]; u32x4 hw; u32x2 qw; lo_encode8(x0, x1, hw, qw); \
      *(u32x4*)(hi + off) = hw; *(u32x2*)(lo + off) = qw; ss += sumsq8(x0, x1); } \
      ss += __shfl_xor(ss, 16); ss += __shfl_xor(ss, 32); if (fq == 0) atomicAdd(rowsq_next + r, ss); } while (0)
    RES_LOAD(0);
#pragma unroll
    for (int st = 0; st < 8; ++st) {
      if (st < 7) RES_LOAD(st + 1);
      __builtin_amdgcn_sched_barrier(0);
      RES_COMP(st);
      __builtin_amdgcn_sched_barrier(0);
    }
#undef RES_LOAD
#undef RES_COMP
  }
};
struct EpiGU {
  const float* rowsq; bf16_t* hid;
  DI void operator()(const AccT& acc, const pg8::Unit& u, int wr, int wc, int fr, int fq) const {
    const int row0 = u.pm * 256 + wr * 64 + fr, c8 = wc * 32 + 8 * fq;
    float rs[2][4];
#pragma unroll
    for (int ai = 0; ai < 2; ++ai)
#pragma unroll
      for (int m = 0; m < 4; ++m) rs[ai][m] = rowsq[row0 + ai * 128 + m * 16];
    __builtin_amdgcn_sched_barrier(0);
#pragma unroll
    for (int ai = 0; ai < 2; ++ai)
#pragma unroll
      for (int m = 0; m < 4; ++m) {
        const int r = row0 + ai * 128 + m * 16;
        const float rstd = rsqrtf(rs[ai][m] * (1.0f / DM) + EPS);
        const float c1 = rstd * -1.44269504089f, r2 = rstd * rstd;
        const f32x4 g0 = acc[ai][0][m][0], g1 = acc[ai][0][m][1];
        const f32x4 o0 = (g0 * acc[ai][1][m][0]) * (sig_scaled(g0, c1) * r2), o1 = (g1 * acc[ai][1][m][1]) * (sig_scaled(g1, c1) * r2);
        __builtin_nontemporal_store(pack8(o0, o1), (u32x4*)(hid + (size_t)r * DFF + u.pn * 128 + c8));
      }
  }
};

DI int map_win(int n) {
  if (n < 512) return 256 * (n >> 7) + (n & 127);
  if (n < 1024) { const int nn = n - 512; return 256 * (nn >> 7) + 128 + (nn & 127); }
  if (n < 2048) { const int which = (n - 1024) >> 9, nn = (n - 1024) & 511, head = nn >> 7, d = nn & 127; return 256 * (4 + 2 * which + (head >> 1)) + 128 * (d >> 6) + 64 * (head & 1) + (d & 63); }
  return n;
}
template <int MODE>
DI void transpose_item(const float* W, int K, int N, const float* gk, bf16_t* WT, LAS float* scr, int item, int lane) {
  const int nblk = N / 64, kb = item / nblk, nb = item % nblk, k0 = 64 * kb, n0 = 64 * nb;
  const float* src = W + (size_t)k0 * N + n0 + lane;
  float w[64];
#pragma unroll
  for (int i = 0; i < 64; ++i) w[i] = src[(size_t)i * N];
  if (gk) {
#pragma unroll
    for (int i = 0; i < 64; ++i) w[i] *= gk[k0 + i];
  }
#pragma unroll
  for (int i = 0; i < 64; ++i) scr[i * 65 + lane] = w[i];
  asm volatile("s_waitcnt lgkmcnt(0)" ::: "memory");
  const int c = lane & 7;
#pragma unroll
  for (int j = 0; j < 8; ++j) { const int n = (lane >> 3) + 8 * j; const LAS float* s = scr + (8 * c) * 65 + n;
    u32x4 o; o.x = cvt_pk_bf16(s[0 * 65], s[1 * 65]); o.y = cvt_pk_bf16(s[2 * 65], s[3 * 65]); o.z = cvt_pk_bf16(s[4 * 65], s[5 * 65]); o.w = cvt_pk_bf16(s[6 * 65], s[7 * 65]);
    const int ng = n0 + n;
    const int nm = MODE == 0 ? ng : MODE == 1 ? map_win(ng) : (256 * (ng >> 7) + (MODE == 3 ? 128 : 0) + (ng & 127));
    *(u32x4*)(WT + (size_t)nm * K + k0 + 8 * c) = o; }
  asm volatile("s_waitcnt lgkmcnt(0)" ::: "memory");
}
DI void phase_prologue(const Params& p, LAS unsigned char* lds) {
  int tid = threadIdx.x; asm volatile("" : "+v"(tid));
  const int lane = tid & 63, wave = tid >> 6;
  const int gw = blockIdx.x * 8 + wave, NGW = gridDim.x * 8;
  LAS float* scr = (LAS float*)(lds + wave * 16640);
  unsigned char* ws = p.ws;
  constexpr int I_IN = 16 * 48, I_OUT = 16 * 16, I_G = 16 * 44, I_DN = 44 * 16, I_LAYER = I_IN + I_OUT + 2 * I_G + I_DN;
  for (int it = gw; it < NLAYER * I_LAYER; it += NGW) {
    const int l = it / I_LAYER; int r = it % I_LAYER;
    if (r < I_IN) { transpose_item<1>(p.in[2] + (size_t)l * DM * INW, DM, INW, p.in[1] + l * DM, (bf16_t*)(ws + OFF_WIN + l * SZ_WIN), scr, r, lane); continue; } r -= I_IN;
    if (r < I_OUT) { transpose_item<0>(p.in[8] + (size_t)l * DM * DM, DM, DM, nullptr, (bf16_t*)(ws + OFF_WOUT + l * SZ_WOUT), scr, r, lane); continue; } r -= I_OUT;
    if (r < I_G) { transpose_item<2>(p.in[10] + (size_t)l * DM * DFF, DM, DFF, p.in[9] + l * DM, (bf16_t*)(ws + OFF_WGU + l * SZ_WGU), scr, r, lane); continue; } r -= I_G;
    if (r < I_G) { transpose_item<3>(p.in[11] + (size_t)l * DM * DFF, DM, DFF, p.in[9] + l * DM, (bf16_t*)(ws + OFF_WGU + l * SZ_WGU), scr, r, lane); continue; } r -= I_G;
    transpose_item<0>(p.in[12] + (size_t)l * DFF * DM, DFF, DM, nullptr, (bf16_t*)(ws + OFF_WDN + l * SZ_WDN), scr, r, lane);
  }
  const float* x = p.in[0]; bf16_t* xb = (bf16_t*)(ws + OFF_XB); float* rowsq = (float*)(ws + OFF_ROWSQ);
  for (int row = gw; row < MTOK; row += 2 * NGW) {
    const int row2 = row + NGW;
    const f32x4* xr = (const f32x4*)(x + (size_t)row * DM) + lane; u32x2* o = (u32x2*)(xb + (size_t)row * DM) + lane;
    const bool has2 = row2 < MTOK;
    const f32x4* xr2 = (const f32x4*)(x + (size_t)(has2 ? row2 : row) * DM) + lane; u32x2* o2 = (u32x2*)(xb + (size_t)(has2 ? row2 : row) * DM) + lane;
    f32x4 v[4], v2[4];
#pragma unroll
    for (int j = 0; j < 4; ++j) { v[j] = xr[64 * j]; v2[j] = xr2[64 * j]; }
    float s = 0.f, s2 = 0.f;
#pragma unroll
    for (int j = 0; j < 4; ++j) { s += (v[j][0] * v[j][0] + v[j][1] * v[j][1]) + (v[j][2] * v[j][2] + v[j][3] * v[j][3]); u32x2 w; w.x = cvt_pk_bf16(v[j][0], v[j][1]); w.y = cvt_pk_bf16(v[j][2], v[j][3]); o[64 * j] = w;
      s2 += (v2[j][0] * v2[j][0] + v2[j][1] * v2[j][1]) + (v2[j][2] * v2[j][2] + v2[j][3] * v2[j][3]); u32x2 w2; w2.x = cvt_pk_bf16(v2[j][0], v2[j][1]); w2.y = cvt_pk_bf16(v2[j][2], v2[j][3]); o2[64 * j] = w2; }
    s = wave_sum(s); s2 = wave_sum(s2);
    if (lane == 0) { rowsq[row] = s; if (has2) rowsq[row2] = s2; }
  }
  const int gt = blockIdx.x * 512 + tid, NGT = gridDim.x * 512;
  for (int i = gt; i < 8 * MTOK; i += NGT) rowsq[MTOK + i] = 0.f;
  float* cs = (float*)(ws + OFF_COS); float* sn = (float*)(ws + OFF_SIN);
  for (int i = gt; i < SEQ * 64; i += NGT) {
    const int pos = i >> 6, fi = i & 63;
    const double freq = exp(-(double)fi * (9.210340371976184 / 64.0));
    const double t = (double)pos * freq * 0.6366197723675814;
    const double qd = rint(t); const double r = (t - qd) * 1.5707963267948966; const double r2 = r * r;
    const double sv = r * (1.0 + r2 * (-1.0 / 6 + r2 * (1.0 / 120 + r2 * (-1.0 / 5040 + r2 * (1.0 / 362880 + r2 * (-1.0 / 39916800))))));
    const double cv = 1.0 + r2 * (-0.5 + r2 * (1.0 / 24 + r2 * (-1.0 / 720 + r2 * (1.0 / 40320 + r2 * (-1.0 / 3628800 + r2 * (1.0 / 479001600))))));
    const int qi = ((int)qd) & 3;
    const double s_ = qi == 0 ? sv : qi == 1 ? cv : qi == 2 ? -sv : -cv;
    const double c_ = qi == 0 ? cv : qi == 1 ? -sv : qi == 2 ? -cv : sv;
    cs[i] = (float)c_; sn[i] = (float)s_;
  }
}

DI void conv_load(const bf16_t* U0, int item, int tid, u32x4 (&pf)[8]) {
  const int b = item >> 8, t0 = (item & 255) * 32;
#pragma unroll
  for (int i = 0; i < 8; ++i) { const int id = tid + 512 * i, row = id >> 6, ch = id & 63, tok = t0 - 30 + row; const bool ok = (id < 62 * 64) && (tok >= 0);
    const u32x4 v = *(const u32x4*)(U0 + ((size_t)(b * SEQ + (ok ? tok : 0))) * 512 + ch * 8);
    pf[i] = ok ? v : (u32x4){0u, 0u, 0u, 0u}; }
}
DI void conv_items(const Params& p, int l, int first, int stride, int limit, LAS unsigned char* lds) {
  int tid = threadIdx.x; asm volatile("" : "+v"(tid));
  const int lane = tid & 63, wave = tid >> 6;
  const bf16_t* U0 = (const bf16_t*)(p.ws + OFF_U0); bf16_t* MIX = (bf16_t*)(p.ws + OFF_MIX);
  LAS unsigned char* in = lds;
  LAS float* st = (LAS float*)(lds + 63488);
  if (first >= limit) return;
  u32x4 pf[8];
  conv_load(U0, first, tid, pf);
  const int cs_ = tid >> 8, cp_ = tid & 255;
  f32x2 wv[CONVK];
  { const float* cw = p.in[3] + (size_t)l * CONVK * CWID + 2 * cp_;
#pragma unroll
    for (int j = 0; j < CONVK; ++j) wv[j] = *(const f32x2*)(cw + j * CWID); }
  const f32x2 bb = *(const f32x2*)(p.in[4] + l * CWID + 2 * cp_);
  const f32x4 g0 = *(const f32x4*)(p.in[5] + l * CWID + lane * 8), g1 = *(const f32x4*)(p.in[5] + l * CWID + lane * 8 + 4), b0 = *(const f32x4*)(p.in[6] + l * CWID + lane * 8), b1 = *(const f32x4*)(p.in[6] + l * CWID + lane * 8 + 4);
  for (int item = first; item < limit; item += stride) {
  const int b = item >> 8, t0 = (item & 255) * 32;
#pragma unroll
  for (int i = 0; i < 8; ++i) { const int id = tid + 512 * i; if (id < 62 * 64) *(LAS u32x4*)(in + (id >> 6) * 1024 + (id & 63) * 16) = pf[i]; }
  __syncthreads();
  if (item + stride < limit) conv_load(U0, item + stride, tid, pf);
  {
    const int s = cs_, cp = cp_;
    f32x2 av[16];
#pragma unroll
    for (int o = 0; o < 16; ++o) av[o] = bb;
#pragma unroll
    for (int ii = 0; ii < 46; ++ii) {
      const unsigned xw = *(const LAS unsigned*)(in + (16 * s + ii) * 1024 + cp * 4); const f32x2 xv = (f32x2){bf_lo(xw), bf_hi(xw)};
#pragma unroll
      for (int o = 0; o < 16; ++o) { const int j = ii - o; if (j >= 0 && j < CONVK) av[o] = __builtin_elementwise_fma(wv[j], xv, av[o]); }
    }
#pragma unroll
    for (int o = 0; o < 16; ++o) *(LAS f32x2*)(st + (16 * s + o) * 516 + 2 * cp) = av[o];
  }
  __syncthreads();
  {
#pragma unroll
    for (int tt = 0; tt < 4; ++tt) {
      const int oo = wave * 4 + tt;
      const LAS float* r = st + oo * 516 + lane * 8;
      const f32x4 A = *(const LAS f32x4*)r, B = *(const LAS f32x4*)(r + 4);
      float s1 = (A[0] + A[1]) + (A[2] + A[3]) + (B[0] + B[1]) + (B[2] + B[3]);
      float s2 = (A[0] * A[0] + A[1] * A[1]) + (A[2] * A[2] + A[3] * A[3]) + (B[0] * B[0] + B[1] * B[1]) + (B[2] * B[2] + B[3] * B[3]);
#pragma unroll
      for (int o = 1; o < 64; o <<= 1) { s1 += __shfl_xor(s1, o); s2 += __shfl_xor(s2, o); }
      const float mean = s1 * (1.0f / CWID);
      const float var = fmaxf(s2 * (1.0f / CWID) - mean * mean, 0.f);
      const f32x4 dA = A - mean, dB = B - mean;
      const float rstd = rsqrtf(var + EPS);
      f32x4 y0 = dA * rstd * g0 + b0, y1 = dB * rstd * g1 + b1;
#pragma unroll
      for (int j = 0; j < 4; ++j) { y0[j] = siluf_(y0[j]); y1[j] = siluf_(y1[j]); }
      *(u32x4*)(MIX + ((size_t)(b * SEQ + t0 + oo)) * DM + lane * 8) = pack8(y0, y1);
    }
  }
  __syncthreads();
  }
}

DI bf16x8 tr_pair(const LAS unsigned char* base, int row_stride) {
  const s16x4 lo = __builtin_amdgcn_ds_read_tr16_b64_v4i16((LAS s16x4*)base);
  const s16x4 hi = __builtin_amdgcn_ds_read_tr16_b64_v4i16((LAS s16x4*)(base + 4 * row_stride));
  return __builtin_shufflevector(lo, hi, 0, 1, 2, 3, 4, 5, 6, 7);
}
template <int PASS>
DI void ret_item(const Params& p, int l, int item, LAS unsigned char* lds) {
  constexpr int RS = 272, PS = 144;
  int tid = threadIdx.x; asm volatile("" : "+v"(tid));
  const int lane = tid & 63, wave = __builtin_amdgcn_readfirstlane(tid >> 6), g = lane >> 4, c16 = lane & 15, tq = c16 >> 2, tp = c16 & 3;
  const int b = item >> 6, h = (item >> 4) & 3, seg = item & 15;
  const size_t tokbase = (size_t)b * SEQ + seg * 512;
  const float log2g = __log2f(1.0f - __builtin_amdgcn_exp2f(-5.0f - (float)h));
  const bf16_t* Qg = (const bf16_t*)(p.ws + OFF_Q) + h * 128; const bf16_t* Kg = (const bf16_t*)(p.ws + OFF_K) + h * 128; const bf16_t* Vg = (const bf16_t*)(p.ws + OFF_V) + h * 128;
  const bf16_t* SGg = (const bf16_t*)(p.ws + OFF_SG) + h * 128; bf16_t* MIX = (bf16_t*)(p.ws + OFF_MIX) + 512 + h * 128;
  f32x4* Lb = (f32x4*)(p.ws + OFF_L);
  LAS unsigned char* Qs = lds; LAS unsigned char* Ks = lds + 17408; LAS unsigned char* Vs = lds + 34816; LAS unsigned char* Ps = lds + 52224; LAS unsigned char* Ss = lds + 61440;
  LAS float* stats = (LAS float*)(lds + 96256);
  u32x4 rq[2], rk[2], rv[2];
  f32x4 Sacc[8];
#define RET_LOAD(n) do { _Pragma("unroll") for (int i_ = 0; i_ < 2; ++i_) { const int id_ = tid + 512 * i_, j_ = id_ >> 4, ch_ = id_ & 15; const size_t o_ = (tokbase + (n) * 64 + j_) * 512 + ch_ * 8; \
      rk[i_] = *(const u32x4*)(Kg + o_); rv[i_] = *(const u32x4*)(Vg + o_); if (PASS == 2) rq[i_] = *(const u32x4*)(Qg + o_); } } while (0)
#define RET_STORE() do { _Pragma("unroll") for (int i_ = 0; i_ < 2; ++i_) { const int id_ = tid + 512 * i_, j_ = id_ >> 4, ch_ = id_ & 15; \
      *(LAS u32x4*)(Ks + j_ * RS + ch_ * 16) = rk[i_]; *(LAS u32x4*)(Vs + j_ * RS + ch_ * 16) = rv[i_]; if (PASS == 2) *(LAS u32x4*)(Qs + j_ * RS + ch_ * 16) = rq[i_]; } } while (0)
#define RET_WRITE_S() do { _Pragma("unroll") for (int dt_ = 0; dt_ < 8; ++dt_) { u32x2 w_; w_.x = cvt_pk_bf16(Sacc[dt_][0], Sacc[dt_][1]); w_.y = cvt_pk_bf16(Sacc[dt_][2], Sacc[dt_][3]); \
      *(LAS u32x2*)(Ss + (16 * dt_ + c16) * RS + (16 * wave + 4 * g) * 2) = w_; } } while (0)
  RET_LOAD(0);
  const int it_c = wave & 3, eh_c = wave >> 2, i_c = 16 * it_c + c16;
  u32x2 sg_cur[4], sg_nxt[4]; f32x4 gnv[4];
  if (PASS == 2) {
#pragma unroll
    for (int et = 0; et < 4; ++et) { const int e0 = 64 * eh_c + 16 * et + 4 * g; gnv[et] = *(const f32x4*)(p.in[7] + l * RWID + h * 128 + e0); sg_nxt[et] = *(const u32x2*)(SGg + (tokbase + i_c) * 512 + e0); }
  }
#pragma unroll
  for (int dt = 0; dt < 8; ++dt) Sacc[dt] = (f32x4){0.f, 0.f, 0.f, 0.f};
  if (PASS == 2) {
    const f32x4* Lp = Lb + (size_t)item * 4096 + (wave * 8) * 64 + lane;
#pragma unroll
    for (int dt = 0; dt < 8; ++dt) Sacc[dt] = Lp[dt * 64];
  }
  RET_STORE();
  if (PASS == 2) RET_WRITE_S();
  __syncthreads();
  const float g64 = __builtin_amdgcn_exp2f(log2g * 64.0f);
  float dB[2][4]; float gi_c = 0.f;
  if (PASS == 2) {
    const int jt_ = wave >> 1, it0_ = 2 * (wave & 1);
#pragma unroll
    for (int t = 0; t < 2; ++t)
#pragma unroll
      for (int r = 0; r < 4; ++r) { const int i = 16 * (it0_ + t) + c16, j = 16 * jt_ + 4 * g + r; dB[t][r] = __builtin_amdgcn_exp2f(log2g * (float)((i > j ? i - j : j - i) + j - 63)); }
    gi_c = __builtin_amdgcn_exp2f(log2g * (float)(i_c + 1));
  }
  for (int n = 0; n < 8; ++n) {
    if (n < 7) RET_LOAD(n + 1);
    if (PASS == 2) {
#pragma unroll
      for (int et = 0; et < 4; ++et) { sg_cur[et] = sg_nxt[et]; if (n < 7) sg_nxt[et] = *(const u32x2*)(SGg + (tokbase + (n + 1) * 64 + i_c) * 512 + 64 * eh_c + 16 * et + 4 * g); }
      {
        const int jt = wave >> 1, it0 = 2 * (wave & 1);
        f32x4 sacc[2] = {(f32x4){0.f, 0.f, 0.f, 0.f}, (f32x4){0.f, 0.f, 0.f, 0.f}};
        bf16x8 ka[4], qb[2][4];
#pragma unroll
        for (int ks = 0; ks < 4; ++ks) { ka[ks] = *(const LAS bf16x8*)(Ks + (16 * jt + c16) * RS + (32 * ks + 8 * g) * 2);
#pragma unroll
          for (int t = 0; t < 2; ++t) qb[t][ks] = *(const LAS bf16x8*)(Qs + (16 * (it0 + t) + c16) * RS + (32 * ks + 8 * g) * 2); }
        __builtin_amdgcn_sched_barrier(0);
#pragma unroll
        for (int ks = 0; ks < 4; ++ks)
#pragma unroll
          for (int t = 0; t < 2; ++t) sacc[t] = __builtin_amdgcn_mfma_f32_16x16x32_bf16(ka[ks], qb[t][ks], sacc[t], 0, 0, 0);
        __builtin_amdgcn_sched_barrier(0);
#pragma unroll
        for (int t = 0; t < 2; ++t) { const int i = 16 * (it0 + t) + c16; float pv[4];
#pragma unroll
          for (int r = 0; r < 4; ++r) pv[r] = sacc[t][r] * dB[t][r];
          u32x2 w_; w_.x = cvt_pk_bf16(pv[0], pv[1]); w_.y = cvt_pk_bf16(pv[2], pv[3]);
          *(LAS u32x2*)(Ps + i * PS + (16 * jt + 4 * g) * 2) = w_; }
      }
    }
    f32x4 accI[4], accX[4];
    const int it = wave & 3, eh = wave >> 2, i = 16 * it + c16;
    if (PASS == 2) {
#pragma unroll
      for (int et = 0; et < 4; ++et) { accI[et] = (f32x4){0.f, 0.f, 0.f, 0.f}; accX[et] = (f32x4){0.f, 0.f, 0.f, 0.f}; }
#pragma unroll
      for (int kh = 0; kh < 2; ++kh) {
        bf16x8 bq[2], as_[2][4];
#pragma unroll
        for (int k2 = 0; k2 < 2; ++k2) { const int ks = 2 * kh + k2; bq[k2] = *(const LAS bf16x8*)(Qs + i * RS + (32 * ks + 8 * g) * 2);
#pragma unroll
          for (int et = 0; et < 4; ++et) as_[k2][et] = tr_pair(Ss + (32 * ks + 8 * g + tq) * RS + (64 * eh + 16 * et + 4 * tp) * 2, RS); }
        __builtin_amdgcn_sched_barrier(0);
#pragma unroll
        for (int k2 = 0; k2 < 2; ++k2)
#pragma unroll
          for (int et = 0; et < 4; ++et) accX[et] = __builtin_amdgcn_mfma_f32_16x16x32_bf16(as_[k2][et], bq[k2], accX[et], 0, 0, 0);
        __builtin_amdgcn_sched_barrier(0);
      }
    }
    if (PASS == 1 || n < 7) {
#pragma unroll
      for (int dt = 0; dt < 8; ++dt) Sacc[dt] *= g64;
#pragma unroll
      for (int ks = 0; ks < 2; ++ks) {
        bf16x8 bk[8];
        const bf16x8 a = tr_pair(Vs + (32 * ks + 8 * g + tq) * RS + (16 * wave + 4 * tp) * 2, RS);
#pragma unroll
        for (int dt = 0; dt < 8; ++dt) bk[dt] = tr_pair(Ks + (32 * ks + 8 * g + tq) * RS + (16 * dt + 4 * tp) * 2, RS);
        __builtin_amdgcn_sched_barrier(0);
#pragma unroll
        for (int dt = 0; dt < 8; ++dt) Sacc[dt] = __builtin_amdgcn_mfma_f32_16x16x32_bf16(a, bk[dt], Sacc[dt], 0, 0, 0);
        __builtin_amdgcn_sched_barrier(0);
      }
    }
    __syncthreads();
    if (PASS == 2) {
      {
        bf16x8 bp[2], av[2][4];
#pragma unroll
        for (int ks = 0; ks < 2; ++ks) { bp[ks] = *(const LAS bf16x8*)(Ps + i * PS + (32 * ks + 8 * g) * 2);
#pragma unroll
          for (int et = 0; et < 4; ++et) av[ks][et] = tr_pair(Vs + (32 * ks + 8 * g + tq) * RS + (64 * eh + 16 * et + 4 * tp) * 2, RS); }
        __builtin_amdgcn_sched_barrier(0);
#pragma unroll
        for (int ks = 0; ks < 2; ++ks)
#pragma unroll
          for (int et = 0; et < 4; ++et) accI[et] = __builtin_amdgcn_mfma_f32_16x16x32_bf16(av[ks][et], bp[ks], accI[et], 0, 0, 0);
        __builtin_amdgcn_sched_barrier(0);
      }
      const float gi = gi_c;
      float s1 = 0.f, s2 = 0.f;
#pragma unroll
      for (int et = 0; et < 4; ++et) { accI[et] += accX[et] * gi;
        s1 += (accI[et][0] + accI[et][1]) + (accI[et][2] + accI[et][3]);
        s2 += (accI[et][0] * accI[et][0] + accI[et][1] * accI[et][1]) + (accI[et][2] * accI[et][2] + accI[et][3] * accI[et][3]); }
      s1 += __shfl_xor(s1, 16); s1 += __shfl_xor(s1, 32); s2 += __shfl_xor(s2, 16); s2 += __shfl_xor(s2, 32);
      if (g == 0) { stats[(eh * 64 + i) * 2] = s1; stats[(eh * 64 + i) * 2 + 1] = s2; }
      __syncthreads();
      const float t1 = stats[i * 2] + stats[(64 + i) * 2], t2 = stats[i * 2 + 1] + stats[(64 + i) * 2 + 1];
      const float mean = t1 * (1.0f / 128.0f), var = fmaxf(t2 * (1.0f / 128.0f) - mean * mean, 0.f), rstd = rsqrtf(var + EPS);
      const size_t tok = tokbase + n * 64 + i;
#pragma unroll
      for (int et = 0; et < 4; ++et) { const int e0 = 64 * eh + 16 * et + 4 * g;
        const f32x4 gn = gnv[et]; const u32x2 sgw = sg_cur[et];
        const float v0 = (accI[et][0] - mean) * rstd * gn[0] * bf_lo(sgw.x), v1 = (accI[et][1] - mean) * rstd * gn[1] * bf_hi(sgw.x);
        const float v2 = (accI[et][2] - mean) * rstd * gn[2] * bf_lo(sgw.y), v3 = (accI[et][3] - mean) * rstd * gn[3] * bf_hi(sgw.y);
        u32x2 w_; w_.x = cvt_pk_bf16(v0, v1); w_.y = cvt_pk_bf16(v2, v3);
        *(u32x2*)(MIX + tok * DM + e0) = w_; }
    }
    if (n < 7) { RET_STORE(); if (PASS == 2) RET_WRITE_S(); }
    __syncthreads();
  }
  if (PASS == 1) {
    f32x4* Lp = Lb + (size_t)item * 4096 + (wave * 8) * 64 + lane;
#pragma unroll
    for (int dt = 0; dt < 8; ++dt) Lp[dt * 64] = Sacc[dt];
  }
#undef RET_LOAD
#undef RET_STORE
#undef RET_WRITE_S
}


DI void ret_scan(const Params& p) {
  f32x4* Lb = (f32x4*)(p.ws + OFF_L);
  int tid_ = threadIdx.x; asm volatile("" : "+v"(tid_));
  const int gt = blockIdx.x * 512 + tid_, NGT = gridDim.x * 512;
  for (int idx = gt; idx < 16 * 4096; idx += NGT) {
    const int bh = idx >> 12, e = idx & 4095, h = bh & 3;
    f32x4* base = Lb + (size_t)bh * 16 * 4096 + e;
    const float g512 = __builtin_amdgcn_exp2f(__log2f(1.0f - __builtin_amdgcn_exp2f(-5.0f - (float)h)) * 512.0f);
    f32x4 v[15];
#pragma unroll
    for (int s_ = 0; s_ < 15; ++s_) v[s_] = base[(size_t)s_ * 4096];
    float z_ = 0.f; asm volatile("" : "+v"(z_));
    f32x4 a = (f32x4){z_, z_, z_, z_};
    base[0] = a;
#pragma unroll
    for (int s_ = 0; s_ < 15; ++s_) { a = a * g512 + v[s_]; base[(size_t)(s_ + 1) * 4096] = a; }
  }
}

#define XB_TMO      128
#define XB_XCNT(j)  (256  + 64 * (j))
#define XB_XSUB(j)  (1280 + 64 * (j))
#define XB_XGEN(j)  (2304 + 64 * (j))
#define XB_TOP      3328
#define XB_TOPGEN   3392
#define XCD_BAR_WORDS 3456
#define XB_SPIN_CAP (1u << 18)
DI unsigned xb_ld(unsigned* p)              { return __hip_atomic_load(p, __ATOMIC_RELAXED, __HIP_MEMORY_SCOPE_AGENT); }
DI unsigned xb_add(unsigned* p, unsigned v) { return __hip_atomic_fetch_add(p, v, __ATOMIC_RELAXED, __HIP_MEMORY_SCOPE_AGENT); }
DI unsigned xb_xcc_id() { return (unsigned)__builtin_amdgcn_s_getreg((3 << 11) | 20) & 0xFu; }
#define XB_SPIN(cond, bar) do { unsigned _sp = 0; while (cond) { __builtin_amdgcn_s_sleep(1); \
    if ((++_sp & 255u) == 0u) { if (xb_ld(&(bar)[XB_TMO])) break; if (_sp > XB_SPIN_CAP) { atomicAdd(&(bar)[XB_TMO], 1u); break; } } } } while (0)
struct XcdBarrier { unsigned* bar; unsigned x; volatile LAS unsigned* st; };
DI XcdBarrier xcd_barrier_post(unsigned* bar, volatile LAS unsigned* st) {
  XcdBarrier b; b.bar = bar; b.x = xb_xcc_id(); b.st = st;
  if (threadIdx.x == 0) (void)xb_add(&bar[XB_XCNT(b.x)], 1u);
  return b;
}
DI void xcd_barrier_complete(unsigned* bar, unsigned x, unsigned& nloc, unsigned& nx) {
  const unsigned G = gridDim.x * gridDim.y * gridDim.z;
  unsigned sum, cnt, mine, sp = 0u;
  for (;;) {
    sum = 0u; cnt = 0u; mine = 0u;
#pragma unroll
    for (unsigned j = 0; j < 16; ++j) { const unsigned c = xb_ld(&bar[XB_XCNT(j)]); sum += c; cnt += (c > 0u) ? 1u : 0u; mine = (j == x) ? c : mine; }
    if (sum == G) break;
    __builtin_amdgcn_s_sleep(1);
    if ((++sp & 255u) == 0u) { if (xb_ld(&bar[XB_TMO])) break; if (sp > XB_SPIN_CAP) { atomicAdd(&bar[XB_TMO], 1u); break; } }
  }
  nloc = mine > 0u ? mine : 1u; nx = cnt > 0u ? cnt : 1u;
}
DI void xcd_barrier(const XcdBarrier& b) {
  asm volatile("s_waitcnt vmcnt(0)" ::: "memory");
  __syncthreads();
  if (threadIdx.x == 0) {
    unsigned* bar = b.bar;
    __builtin_amdgcn_s_waitcnt(0);
    unsigned nloc = b.st[0], nx = b.st[1];
    if (nloc == 0u) { xcd_barrier_complete(bar, b.x, nloc, nx); b.st[0] = nloc; b.st[1] = nx; }
    const unsigned old = xb_add(&bar[XB_XSUB(b.x)], 1u);
    const unsigned gen = old / nloc;
    if (old + 1u == (gen + 1u) * nloc) {
      __builtin_amdgcn_fence(__ATOMIC_RELEASE, "agent");
      asm volatile("s_waitcnt vmcnt(0)" ::: "memory");
      const unsigned og = xb_add(&bar[XB_TOP], 1u);
      const unsigned tg = og / nx;
      if (og + 1u == (tg + 1u) * nx) xb_add(&bar[XB_TOPGEN], 1u);
      else XB_SPIN(xb_ld(&bar[XB_TOPGEN]) == tg, bar);
      __builtin_amdgcn_fence(__ATOMIC_ACQUIRE, "agent");
      xb_add(&bar[XB_XGEN(b.x)], 1u);
      asm volatile("s_waitcnt vmcnt(0)" ::: "memory");
    } else {
      XB_SPIN(xb_ld(&bar[XB_XGEN(b.x)]) == gen, bar);
      __builtin_amdgcn_fence(__ATOMIC_ACQUIRE, "agent");
      asm volatile("s_waitcnt vmcnt(0)" ::: "memory");
    }
  }
  __syncthreads();
}

extern __shared__ __attribute__((aligned(16))) unsigned char smem_dyn[];

__global__ void __launch_bounds__(512) fwd_mega(Params p) {
  cg::grid_group grid = cg::this_grid();
  LAS unsigned char* lds = (LAS unsigned char*)smem_dyn;
  unsigned char* ws = p.ws;
  float* rowsq = (float*)(ws + OFF_ROWSQ);
  bf16_t* XB = (bf16_t*)(ws + OFF_XB); unsigned char* XLO = ws + OFF_XLO;
  const int G = gridDim.x, c = blockIdx.x;
  volatile LAS unsigned* bst = (volatile LAS unsigned*)(lds + 133120);
  if (threadIdx.x == 0) { bst[0] = 0u; bst[1] = 0u; }
  __syncthreads();
  const XcdBarrier xbar = xcd_barrier_post((unsigned*)(ws + OFF_BAR), bst);
#define GSYNC() xcd_barrier(xbar)

  phase_prologue(p, lds);
  grid.sync();

  for (int l = 0; l < NLAYER; ++l) {
    { pg8::Gemm gm{XB, (const bf16_t*)(ws + OFF_WIN + l * SZ_WIN), MTOK, INW, DM};
      pg8::StaticOrder so; so.init(MTOK, INW, G, c);
      EpiIn e{rowsq + (size_t)(2 * l) * MTOK, (bf16_t*)(ws + OFF_U0), (bf16_t*)(ws + OFF_Q), (bf16_t*)(ws + OFF_K), (bf16_t*)(ws + OFF_V), (bf16_t*)(ws + OFF_SG), (const float*)(ws + OFF_COS), (const float*)(ws + OFF_SIN)};
      pg8::gemm_phase(lds, gm, so, e); }
    GSYNC();
    for (int it = c; it < 256; it += G) ret_item<1>(p, l, it, lds);
    if (G == 256) { const int x_ = c & 7, j_ = c >> 3; conv_items(p, l, 128 * x_ + j_, 32, 128 * x_ + 128, lds); }
    else conv_items(p, l, c, G, 1024, lds);
    GSYNC();
    ret_scan(p);
    GSYNC();
    for (int it = c; it < 256; it += G) ret_item<2>(p, l, it, lds);
    GSYNC();
    { pg8::Gemm gm{(const bf16_t*)(ws + OFF_MIX), (const bf16_t*)(ws + OFF_WOUT + l * SZ_WOUT), MTOK, DM, DM};
      pg8::StaticOrder so; so.init(MTOK, DM, G, c);
      EpiRes e{p.in[0], p.out, XB, XLO, rowsq + (size_t)(2 * l + 1) * MTOK, l == 0, 0, p.in[13], (unsigned*)(ws + OFF_BAR) + 3584};
      pg8::gemm_phase(lds, gm, so, e);
 }
    GSYNC();
    { pg8::Gemm gm{XB, (const bf16_t*)(ws + OFF_WGU + l * SZ_WGU), MTOK, 2 * DFF, DM};
      pg8::StaticOrder so; so.init(MTOK, 2 * DFF, G, c);
      EpiGU e{rowsq + (size_t)(2 * l + 1) * MTOK, (bf16_t*)(ws + OFF_HID)};
      pg8::gemm_phase(lds, gm, so, e);
 }
    GSYNC();
    { pg8::Gemm gm{(const bf16_t*)(ws + OFF_HID), (const bf16_t*)(ws + OFF_WDN + l * SZ_WDN), MTOK, DM, DFF};
      pg8::StaticOrder so; so.init(MTOK, DM, G, c);
      EpiRes e{p.in[0], p.out, XB, XLO, rowsq + (size_t)(2 * l + 2) * MTOK, 0, l == NLAYER - 1, p.in[13], (unsigned*)(ws + OFF_BAR) + 3584};
      pg8::gemm_phase(lds, gm, so, e);
 }
    if (l < NLAYER - 1) GSYNC();
  }
}

extern "C" void kernel_launch(void* const* d_in, const int* in_sizes, int n_in, void* d_out, int out_size, void* d_ws, size_t ws_size, hipStream_t stream) {
  static int grid_blocks = 0;
  if (!grid_blocks) {
    int dev = 0, cus = 0, per_cu = 0;
    (void)hipGetDevice(&dev);
    (void)hipDeviceGetAttribute(&cus, hipDeviceAttributeMultiprocessorCount, dev);
    (void)hipFuncSetAttribute((const void*)fwd_mega, hipFuncAttributeMaxDynamicSharedMemorySize, LDS_BYTES);
    (void)hipOccupancyMaxActiveBlocksPerMultiprocessor(&per_cu, (const void*)fwd_mega, 512, LDS_BYTES);
    if (n_in != 14 || out_size != MTOK * DM || ws_size < WS_END) { fprintf(stderr, "kernel_launch: unexpected shapes (n_in %d out %d ws %zu need %zu)\n", n_in, out_size, ws_size, (size_t)WS_END); grid_blocks = -1; return; }
    grid_blocks = cus;
    fprintf(stderr, "kernel_launch: cus %d per_cu %d grid %d\n", cus, per_cu, grid_blocks);
  }
  if (grid_blocks < 0) return;
  (void)hipMemsetAsync((unsigned char*)d_ws + OFF_BAR, 0, 16384, stream);
  Params p{};
  for (int i = 0; i < 14; ++i) p.in[i] = (const float*)d_in[i];
  p.out = (float*)d_out; p.ws = (unsigned char*)d_ws;
  void* args[] = {&p};
  hipError_t e = hipLaunchCooperativeKernel((void*)fwd_mega, dim3(grid_blocks), dim3(512), args, LDS_BYTES, stream);
  if (e != hipSuccess) fprintf(stderr, "cooperative launch failed: %s (grid %d)\n", hipGetErrorString(e), grid_blocks);
}
```
